# Optimizing an MI355X kernel written in HIP

```python
import math
import jax, jax.numpy as jnp
from jax import lax
import numpy as np

D_MODEL = 1024
BATCH = 16
SEQ = 2048
DEPTH = 4

N_MIXERS = 2
MLA_HEADS = 8
MLA_Q_RANK = 384
MLA_KV_RANK = 256
MLA_NOPE_DIM = 128
MLA_ROPE_DIM = 64
MLA_V_DIM = 128
ROPE_THETA = 10000.0
MOBA_HEADS = 8
MOBA_HEAD_DIM = D_MODEL // MOBA_HEADS
MOBA_BLOCK = 256
MOBA_TOP_K = 3
REL_BUCKETS = 32
REL_MAX_DISTANCE = 1024
D_FF = 4 * D_MODEL
Q_BLOCK = 128
RMS_EPS = 1e-6
N_MLA_LAYERS = (DEPTH + 1) // 2
N_MOBA_LAYERS = DEPTH // 2

kernel_name = "hybrid_mla_moba_sqrelu_trunk"


def rms_norm(x, g):
    xf = x.astype(jnp.float32)
    y = xf * lax.rsqrt(jnp.mean(xf * xf, axis=-1, keepdims=True) + RMS_EPS)
    return (y * g.astype(jnp.float32)).astype(x.dtype)


def rope_tables(positions):
    inv_freq = ROPE_THETA ** (-jnp.arange(0, MLA_ROPE_DIM, 2, dtype=jnp.float32) / MLA_ROPE_DIM)
    ang = positions.astype(jnp.float32)[..., None] * inv_freq
    return jnp.cos(ang), jnp.sin(ang)


def rope(x, cos, sin):
    half = x.shape[-1] // 2
    x1 = x[..., :half].astype(jnp.float32)
    x2 = x[..., half:].astype(jnp.float32)
    return jnp.concatenate([x1 * cos - x2 * sin, x2 * cos + x1 * sin], axis=-1).astype(x.dtype)


def t5_bucket(dist):
    n = jnp.maximum(dist, 0)
    max_exact = REL_BUCKETS // 2
    nf = jnp.maximum(n, 1).astype(jnp.float32)
    large = max_exact + (jnp.log(nf / max_exact) / math.log(REL_MAX_DISTANCE / max_exact)
                         * (REL_BUCKETS - max_exact)).astype(jnp.int32)
    large = jnp.minimum(large, REL_BUCKETS - 1)
    return jnp.where(n < max_exact, n, large)


def sq_relu_mlp(h, w_in, w_out):
    a = jax.nn.relu(h @ w_in)
    return (a * a) @ w_out


def mla_attention(q_nope, q_pe, k_nope, k_pe, v):
    B, H, S, _ = q_nope.shape
    nqb = S // Q_BLOCK
    scale = 1.0 / math.sqrt(MLA_NOPE_DIM + MLA_ROPE_DIM)
    k_idx = jnp.arange(S)

    def to_blocks(t):
        return jnp.moveaxis(t.reshape(B, H, nqb, Q_BLOCK, t.shape[-1]), 2, 0)

    def body(args):
        qn, qp, c = args
        logits = (jnp.einsum('bhqd,bhkd->bhqk', qn, k_nope)
                  + jnp.einsum('bhqd,bkd->bhqk', qp, k_pe)).astype(jnp.float32) * scale
        q_idx = c * Q_BLOCK + jnp.arange(Q_BLOCK)
        causal = k_idx[None, :] <= q_idx[:, None]
        logits = jnp.where(causal, logits, -jnp.inf)
        p = jax.nn.softmax(logits, axis=-1).astype(v.dtype)
        return jnp.einsum('bhqk,bhkd->bhqd', p, v)

    out = lax.map(body, (to_blocks(q_nope), to_blocks(q_pe), jnp.arange(nqb, dtype=jnp.int32)))
    return jnp.moveaxis(out, 0, 2).reshape(B, H, S, v.shape[-1])


def mla_mixer(h, w_in, q_a_norm, kv_a_norm, w_uq, w_ukv, q_nope_norm, q_rope_norm,
              k_nope_norm, k_rope_norm, w_o, cos, sin):
    B, S, _ = h.shape
    proj = h @ w_in
    c_q = proj[..., :MLA_Q_RANK]
    c_kv = proj[..., MLA_Q_RANK:MLA_Q_RANK + MLA_KV_RANK]
    k_pe = proj[..., MLA_Q_RANK + MLA_KV_RANK:]
    q = (rms_norm(c_q, q_a_norm) @ w_uq).reshape(B, S, MLA_HEADS, MLA_NOPE_DIM + MLA_ROPE_DIM)
    kv = (rms_norm(c_kv, kv_a_norm) @ w_ukv).reshape(B, S, MLA_HEADS, MLA_NOPE_DIM + MLA_V_DIM)
    q_nope = rms_norm(q[..., :MLA_NOPE_DIM], q_nope_norm)
    q_pe = rope(rms_norm(q[..., MLA_NOPE_DIM:], q_rope_norm), cos[:, :, None, :], sin[:, :, None, :])
    k_nope = rms_norm(kv[..., :MLA_NOPE_DIM], k_nope_norm)
    v = kv[..., MLA_NOPE_DIM:]
    k_pe = rope(rms_norm(k_pe, k_rope_norm), cos, sin)
    out = mla_attention(q_nope.transpose(0, 2, 1, 3), q_pe.transpose(0, 2, 1, 3),
                        k_nope.transpose(0, 2, 1, 3), k_pe, v.transpose(0, 2, 1, 3))
    return out.transpose(0, 2, 1, 3).reshape(B, S, MLA_HEADS * MLA_V_DIM) @ w_o


def moba_attention(q, k, v, positions, rel_bias_table):
    B, H, S, dh = q.shape
    nb = -(-S // MOBA_BLOCK)
    pad = nb * MOBA_BLOCK - S
    n_sel = min(MOBA_TOP_K, nb - 1)
    nqb = S // Q_BLOCK
    scale = 1.0 / math.sqrt(dh)
    kb = jnp.pad(k, ((0, 0), (0, 0), (0, pad), (0, 0))).reshape(B, H, nb, MOBA_BLOCK, dh)
    vb = jnp.pad(v, ((0, 0), (0, 0), (0, pad), (0, 0))).reshape(B, H, nb, MOBA_BLOCK, dh)
    k_mean = jnp.mean(kb.astype(jnp.float32), axis=3)
    pos_b = jnp.pad(positions, ((0, 0), (0, pad)), mode='edge').reshape(B, nb, MOBA_BLOCK)
    pos_q = jnp.moveaxis(positions.reshape(B, nqb, Q_BLOCK), 1, 0)
    q_blocks = jnp.moveaxis(q.reshape(B, H, nqb, Q_BLOCK, dh), 2, 0)
    table_h = rel_bias_table.T
    b_i = jnp.arange(B)[:, None, None]
    h_i = jnp.arange(H)[None, :, None]
    h_i4 = jnp.arange(H)[None, :, None, None]
    blk_ids = jnp.arange(nb)
    t_ids = jnp.arange(MOBA_BLOCK)

    def rel_bias(pq, pk):
        return table_h[h_i4, t5_bucket(pq - pk)].astype(jnp.float32)

    def body(args):
        qi, pq, c = args
        q_start = c * Q_BLOCK
        own = q_start // MOBA_BLOCK
        q_idx = q_start + jnp.arange(Q_BLOCK)
        pq4 = pq[:, None, :, None]
        parts = []
        sel = None
        if n_sel > 0:
            gate = jnp.einsum('bhqd,bhnd->bhqn', qi.astype(jnp.float32), k_mean)
            gate = jnp.where(blk_ids < own, gate, -jnp.inf)
            _, sel = lax.top_k(gate, n_sel)
            for r in range(n_sel):
                sel_r = sel[..., r]
                k_sel = kb[b_i, h_i, sel_r]
                lg = (jnp.einsum('bhqd,bhqtd->bhqt', qi, k_sel).astype(jnp.float32) * scale
                      + rel_bias(pq4, pos_b[b_i, sel_r]))
                parts.append(jnp.where(r < own, lg, -jnp.inf))
        k_own = lax.dynamic_index_in_dim(kb, own, axis=2, keepdims=False)
        v_own = lax.dynamic_index_in_dim(vb, own, axis=2, keepdims=False)
        pos_own = lax.dynamic_index_in_dim(pos_b, own, axis=1, keepdims=False)
        lg_own = (jnp.einsum('bhqd,bhtd->bhqt', qi, k_own).astype(jnp.float32) * scale
                  + rel_bias(pq4, pos_own[:, None, None, :]))
        causal = (own * MOBA_BLOCK + t_ids)[None, :] <= q_idx[:, None]
        parts.append(jnp.where(causal, lg_own, -jnp.inf))
        p = jax.nn.softmax(jnp.concatenate(parts, axis=-1), axis=-1).astype(v.dtype)
        p = p.reshape(B, H, Q_BLOCK, n_sel + 1, MOBA_BLOCK)
        out = jnp.einsum('bhqt,bhtd->bhqd', p[..., n_sel, :], v_own)
        for r in range(n_sel):
            v_sel = vb[b_i, h_i, sel[..., r]]
            out = out + jnp.einsum('bhqt,bhqtd->bhqd', p[..., r, :], v_sel)
        return out

    out = lax.map(body, (q_blocks, pos_q, jnp.arange(nqb, dtype=jnp.int32)))
    return jnp.moveaxis(out, 0, 2).reshape(B, H, S, dh)


def moba_mixer(h, w_qkv, q_norm, k_norm, w_o, positions, rel_bias_table):
    B, S, _ = h.shape
    qkv = (h @ w_qkv).reshape(B, S, 3, MOBA_HEADS, MOBA_HEAD_DIM)
    q = rms_norm(qkv[:, :, 0], q_norm).transpose(0, 2, 1, 3)
    k = rms_norm(qkv[:, :, 1], k_norm).transpose(0, 2, 1, 3)
    v = qkv[:, :, 2].transpose(0, 2, 1, 3)
    out = moba_attention(q, k, v, positions, rel_bias_table)
    return out.transpose(0, 2, 1, 3).reshape(B, S, MOBA_HEADS * MOBA_HEAD_DIM) @ w_o


def setup_inputs(seed: int = 0) -> dict:
    key = jax.random.key(seed)
    ks = jax.random.split(key, 24)

    def nrm(k, shape, scale):
        return scale * jax.random.normal(k, shape, jnp.float32)

    def gain(k, shape):
        return 1.0 + 0.05 * jax.random.normal(k, shape, jnp.float32)

    qk_dim = MLA_NOPE_DIM + MLA_ROPE_DIM
    offset = jax.random.randint(ks[1], (BATCH,), 0, 4096, dtype=jnp.int32)
    positions = offset[:, None] + jnp.arange(SEQ, dtype=jnp.int32)[None, :]
    return {
        "x": nrm(ks[0], (BATCH, SEQ, D_MODEL), 1.0),
        "positions": positions,
        "rel_bias_table": nrm(ks[2], (REL_BUCKETS, MOBA_HEADS), 0.5),
        "attn_norm": gain(ks[3], (DEPTH, D_MODEL)),
        "mlp_norm": gain(ks[4], (DEPTH, D_MODEL)),
        "mla_w_in": nrm(ks[5], (N_MLA_LAYERS, D_MODEL, MLA_Q_RANK + MLA_KV_RANK + MLA_ROPE_DIM), D_MODEL ** -0.5),
        "mla_q_a_norm": gain(ks[6], (N_MLA_LAYERS, MLA_Q_RANK)),
        "mla_kv_a_norm": gain(ks[7], (N_MLA_LAYERS, MLA_KV_RANK)),
        "mla_w_uq": nrm(ks[8], (N_MLA_LAYERS, MLA_Q_RANK, MLA_HEADS * qk_dim), MLA_Q_RANK ** -0.5),
        "mla_w_ukv": nrm(ks[9], (N_MLA_LAYERS, MLA_KV_RANK, MLA_HEADS * (MLA_NOPE_DIM + MLA_V_DIM)), MLA_KV_RANK ** -0.5),
        "mla_q_nope_norm": gain(ks[10], (N_MLA_LAYERS, MLA_NOPE_DIM)),
        "mla_q_rope_norm": gain(ks[11], (N_MLA_LAYERS, MLA_ROPE_DIM)),
        "mla_k_nope_norm": gain(ks[12], (N_MLA_LAYERS, MLA_NOPE_DIM)),
        "mla_k_rope_norm": gain(ks[13], (N_MLA_LAYERS, MLA_ROPE_DIM)),
        "mla_w_o": nrm(ks[14], (N_MLA_LAYERS, MLA_HEADS * MLA_V_DIM, D_MODEL), (MLA_HEADS * MLA_V_DIM) ** -0.5),
        "moba_w_qkv": nrm(ks[15], (N_MOBA_LAYERS, D_MODEL, 3 * MOBA_HEADS * MOBA_HEAD_DIM), D_MODEL ** -0.5),
        "moba_q_norm": gain(ks[16], (N_MOBA_LAYERS, MOBA_HEAD_DIM)),
        "moba_k_norm": gain(ks[17], (N_MOBA_LAYERS, MOBA_HEAD_DIM)),
        "moba_w_o": nrm(ks[18], (N_MOBA_LAYERS, MOBA_HEADS * MOBA_HEAD_DIM, D_MODEL), (MOBA_HEADS * MOBA_HEAD_DIM) ** -0.5),
        "mlp_w_in": nrm(ks[19], (DEPTH, D_MODEL, D_FF), D_MODEL ** -0.5),
        "mlp_w_out": nrm(ks[20], (DEPTH, D_FF, D_MODEL), D_FF ** -0.5),
    }


def reference(x, positions, rel_bias_table, attn_norm, mlp_norm, mla_w_in, mla_q_a_norm, mla_kv_a_norm,
              mla_w_uq, mla_w_ukv, mla_q_nope_norm, mla_q_rope_norm, mla_k_nope_norm, mla_k_rope_norm,
              mla_w_o, moba_w_qkv, moba_q_norm, moba_k_norm, moba_w_o, mlp_w_in, mlp_w_out):
    cos, sin = rope_tables(positions)
    for i in range(DEPTH):
        h = rms_norm(x, attn_norm[i])
        j = i // N_MIXERS
        if i % N_MIXERS == 0:
            x = x + mla_mixer(h, mla_w_in[j], mla_q_a_norm[j], mla_kv_a_norm[j], mla_w_uq[j], mla_w_ukv[j],
                              mla_q_nope_norm[j], mla_q_rope_norm[j], mla_k_nope_norm[j], mla_k_rope_norm[j],
                              mla_w_o[j], cos, sin)
        else:
            x = x + moba_mixer(h, moba_w_qkv[j], moba_q_norm[j], moba_k_norm[j], moba_w_o[j],
                               positions, rel_bias_table)
        h = rms_norm(x, mlp_norm[i])
        x = x + sq_relu_mlp(h, mlp_w_in[i], mlp_w_out[i])
    return x
```

```cpp
#include <hip/hip_runtime.h>
#include <hip/hip_cooperative_groups.h>
#include <cstdio>
#include <cstdint>
namespace cg = cooperative_groups;

namespace pg8 {
#define PG8_LAS __attribute__((address_space(3)))
typedef __attribute__((address_space(3))) float* PG8_LAS_F;
typedef unsigned short bf16_t;
typedef short bf16x8 __attribute__((ext_vector_type(8)));
typedef float f32x4 __attribute__((ext_vector_type(4)));
typedef unsigned u32x4 __attribute__((ext_vector_type(4)));
constexpr int BM = 256, BK = 64, HALF = 128, HTB = HALF * BK * 2  , STAGE_BYTES = 8 * HTB, NXCD = 8, WGM = 8;

__host__ __device__ __forceinline__ int lds_byte(int r, int c) { const int st = (r >> 4) * 2 + (c >> 5), rr = r & 15, cc = c & 31, ob = rr * 64 + cc * 2; return st * 1024 + (ob ^ (((ob >> 9) & 1) << 5)); }
__host__ __device__ __forceinline__ void stage_rc(int b, int& R, int& C) { const int st = b / 1024, sb = b % 1024, swz = sb ^ (((sb >> 9) & 1) << 5); R = (st >> 1) * 16 + swz / 64; C = (st & 1) * 32 + (swz % 64) / 2; }
__host__ __device__ __forceinline__ int perm32(int rho) { const int n = rho >> 4, i = rho & 15; return 8 * (i >> 2) + 4 * n + (i & 3); }

struct Unit { int pm, pn; };
struct Gemm { const bf16_t* A; const bf16_t* Bt; int M, N, K; };

struct StaticOrder {
    int nM, nN, nwg, G, c;
    __host__ __device__ void init(int M, int N, int G_, int c_) { nM = M / BM; nN = N / BM; nwg = nM * nN; G = G_; c = c_; }
    __host__ __device__ bool next(int i, Unit& u) const {
        const long L = (long)i * G + c; if (L >= nwg) return false;
        int wgid = (int)L; { const int q = nwg / NXCD, r = nwg % NXCD, xcd = wgid % NXCD, off = wgid / NXCD; wgid = (xcd < r ? xcd * (q + 1) : r * (q + 1) + (xcd - r) * q) + off; }
        const int nig = WGM * nN, gid = wgid / nig, fm = gid * WGM, gsz = (nM - fm) < WGM ? (nM - fm) : WGM;
        u.pm = fm + ((wgid % nig) % gsz); u.pn = (wgid % nig) / gsz; return true;
    }
    __device__ __forceinline__ void a_ready(const Unit&) const {}
    __device__ __forceinline__ void done(const Unit&) const {}
};

typedef float f32x2 __attribute__((ext_vector_type(2)));
typedef __bf16 bf16x2_t __attribute__((ext_vector_type(2)));
__device__ __forceinline__ unsigned cvt_pk_bf16(float lo, float hi) { f32x2 v = {lo, hi}; bf16x2_t b = __builtin_convertvector(v, bf16x2_t); return __builtin_bit_cast(unsigned, b); }

constexpr float RMS_EPS_F = 1e-6f;
template <int MODE> struct EpiGen {
    static constexpr bool PERM = true, AFTER_DRAIN = false;
    const float* ssq_in; int nslot; float inv_k;
    bf16_t* O; int ldc; bf16_t* O2; bf16_t* O3; int split2;
    float* ssq_o1; float* ssq_o2;
    const float* base; float* out;
    const float* kgain; float* kmean; int kmode; PG8_LAS float* xl;
    __device__ __forceinline__ void epi_knorm(const f32x4 (&acc)[2][2][4][2], const Unit& u, int wr, int wc, int fr, int fq) const {
        const int hf0 = 2 * u.pn;
        const bool isk0 = (kmode == 1) ? true : (hf0 >= 8 && hf0 < 16), isk1 = (kmode == 1) ? false : isk0;
        const bool anyk = isk0 || isk1;
        PG8_LAS float* X = xl; PG8_LAS float* Y = xl + 2048;
        float sc[2][4];
#pragma unroll
        for (int ai = 0; ai < 2; ++ai)
#pragma unroll
            for (int m = 0; m < 4; ++m) {
                const int row = u.pm * BM + ai * HALF + wr * 64 + m * 16 + fr;
                sc[ai][m] = 1.f;
                if (kmode == 1 || hf0 >= 16) { const f32x4* sp = (const f32x4*)(ssq_in + (size_t)row * 16); f32x4 t = sp[0]; if (nslot > 4) t += sp[1]; if (nslot > 8) t += sp[2]; if (nslot > 12) t += sp[3];
                    sc[ai][m] = __builtin_amdgcn_rsqf(((t[0] + t[1]) + (t[2] + t[3])) * inv_k + RMS_EPS_F); }
            }
        if (anyk) {
#pragma unroll
            for (int ai = 0; ai < 2; ++ai)
#pragma unroll
                for (int m = 0; m < 4; ++m)
#pragma unroll
                    for (int bj = 0; bj < 2; ++bj) {
                        if (bj == 0 ? isk0 : isk1) {
                            const f32x4 v0 = acc[ai][bj][m][0] * sc[ai][m], v1 = acc[ai][bj][m][1] * sc[ai][m];
                            float part = (v0[0] * v0[0] + v0[1] * v0[1]) + (v0[2] * v0[2] + v0[3] * v0[3]) + (v1[0] * v1[0] + v1[1] * v1[1]) + (v1[2] * v1[2] + v1[3] * v1[3]);
                            part += __shfl_xor(part, 16); part += __shfl_xor(part, 32);
                            if (fq == 0) X[((ai * HALF + wr * 64 + m * 16 + fr) * 2 + bj) * 4 + wc] = part;
                        }
                    }
            asm volatile("s_waitcnt lgkmcnt(0)" ::: "memory"); __builtin_amdgcn_s_barrier(); asm volatile("" ::: "memory");
        }
        float cs[2][8];
#pragma unroll
        for (int bj = 0; bj < 2; ++bj)
#pragma unroll
            for (int e = 0; e < 8; ++e) cs[bj][e] = 0.f;
        const f32x4 g0 = *(const f32x4*)(kgain + wc * 32 + 8 * fq), g1 = *(const f32x4*)(kgain + wc * 32 + 8 * fq + 4);
#pragma unroll
        for (int ai = 0; ai < 2; ++ai)
#pragma unroll
            for (int m = 0; m < 4; ++m) {
                const int rowl = ai * HALF + wr * 64 + m * 16 + fr, row = u.pm * BM + rowl;
#pragma unroll
                for (int bj = 0; bj < 2; ++bj) {
                    const int hf = hf0 + bj;
                    f32x4 v0 = acc[ai][bj][m][0] * sc[ai][m], v1 = acc[ai][bj][m][1] * sc[ai][m];
                    if (bj == 0 ? isk0 : isk1) {
                        const f32x4 t = *(const PG8_LAS f32x4*)(X + (rowl * 2 + bj) * 4);
                        const float sk = __builtin_amdgcn_rsqf(((t[0] + t[1]) + (t[2] + t[3])) * (1.0f / 128.0f) + RMS_EPS_F);
                        v0 = v0 * sk * g0; v1 = v1 * sk * g1;
#pragma unroll
                        for (int e = 0; e < 4; ++e) { cs[bj][e] += v0[e]; cs[bj][4 + e] += v1[e]; }
                    }
                    bf16_t* dst;
                    if (split2) dst = ((hf & 1) ? O2 : O) + (size_t)row * ldc + (hf >> 1) * 128 + wc * 32 + 8 * fq;
                    else dst = O + (size_t)row * ldc + hf * 128 + wc * 32 + 8 * fq;
                    u32x4 w; w.x = cvt_pk_bf16(v0[0], v0[1]); w.y = cvt_pk_bf16(v0[2], v0[3]); w.z = cvt_pk_bf16(v1[0], v1[1]); w.w = cvt_pk_bf16(v1[2], v1[3]);
                    *(u32x4*)dst = w;
                }
                asm volatile("" ::: "memory");
            }
        if (kmean != nullptr && anyk) {
#pragma unroll
            for (int bj = 0; bj < 2; ++bj)
#pragma unroll
                for (int e = 0; e < 8; ++e) { float c = cs[bj][e]; c += __shfl_xor(c, 1); c += __shfl_xor(c, 2); c += __shfl_xor(c, 4); c += __shfl_xor(c, 8); cs[bj][e] = c; }
            if (fr == 0) {
#pragma unroll
                for (int bj = 0; bj < 2; ++bj)
#pragma unroll
                    for (int e = 0; e < 8; ++e) Y[(wr * 2 + bj) * 128 + wc * 32 + 8 * fq + e] = cs[bj][e];
            }
            asm volatile("s_waitcnt lgkmcnt(0)" ::: "memory"); __builtin_amdgcn_s_barrier(); asm volatile("" ::: "memory");
            const int t = (wr * 4 + wc) * 64 + fq * 16 + fr;
            if (t < 256) { const int bj = t >> 7, c = t & 127; const float sum = Y[(0 * 2 + bj) * 128 + c] + Y[(1 * 2 + bj) * 128 + c];
                const int head = hf0 + bj - 8, b = u.pm >> 3, blk = u.pm & 7;
                kmean[((size_t)(b * 8 + head) * 8 + blk) * 128 + c] = sum * (1.0f / 256.0f); }
        }
    }
    __device__ __forceinline__ void operator()(const f32x4 (&acc)[2][2][4][2], const Unit& u, int wr, int wc, int fr, int fq) const {
        if (MODE == 4) { epi_knorm(acc, u, wr, wc, fr, fq); return; }
        const int row0 = u.pm * BM + wr * 64 + fr;
        u32x4 bnn[4][2];
#define EPI_LOADH(ai_) do { if (MODE == 3) { _Pragma("unroll") for (int m_ = 0; m_ < 4; ++m_) _Pragma("unroll") for (int bj_ = 0; bj_ < 2; ++bj_) \
            bnn[m_][bj_] = *(const u32x4*)(O + (size_t)(row0 + (ai_) * HALF + m_ * 16) * ldc + u.pn * BM + bj_ * HALF + wc * 32 + 8 * fq); } } while (0)
        EPI_LOADH(0);
        const bool has_scale = nslot > 0;
        if (has_scale) {
            const int t_ = (wr * 4 + wc) * 64 + fq * 16 + fr;
            if (t_ < 256) { const f32x4* sp_ = (const f32x4*)(ssq_in + (size_t)(u.pm * BM + t_) * 16); f32x4 x_ = sp_[0]; if (nslot > 4) x_ += sp_[1]; if (nslot > 8) x_ += sp_[2]; if (nslot > 12) x_ += sp_[3];
                const float ms_ = ((x_[0] + x_[1]) + (x_[2] + x_[3])) * inv_k + RMS_EPS_F;
                xl[2560 + t_] = (MODE == 3) ? __builtin_amdgcn_rcpf(ms_) : __builtin_amdgcn_rsqf(ms_); }
            asm volatile("s_waitcnt lgkmcnt(0)" ::: "memory"); __builtin_amdgcn_s_barrier(); asm volatile("" ::: "memory");
        }
#pragma unroll
        for (int ai = 0; ai < 2; ++ai) {
            if (ai == 1) EPI_LOADH(1);
#pragma unroll
            for (int m = 0; m < 4; ++m) {
                const int row = row0 + ai * HALF + m * 16;
                float sc = 1.f; u32x4 bw0, bw1;
                if (has_scale) sc = xl[2560 + ai * HALF + wr * 64 + m * 16 + fr];
                if (MODE == 3) { bw0 = bnn[m][0]; bw1 = bnn[m][1]; }
                if (MODE == 0 || MODE == 1) {
#pragma unroll
                    for (int bj = 0; bj < 2; ++bj) {
                        const int hf = 2 * u.pn + bj;
                        bf16_t* dst;
                        if (split2) dst = ((hf & 1) ? O2 : O) + (size_t)row * ldc + (hf >> 1) * 128 + wc * 32 + 8 * fq;
                        else dst = O + (size_t)row * ldc + hf * 128 + wc * 32 + 8 * fq;
                        f32x4 v0 = acc[ai][bj][m][0] * sc, v1 = acc[ai][bj][m][1] * sc;
                        if (MODE == 1) {
#pragma unroll
                            for (int e = 0; e < 4; ++e) { float a = fmaxf(v0[e], 0.f), b = fmaxf(v1[e], 0.f); v0[e] = a * a; v1[e] = b * b; }
                        }
                        u32x4 w; w.x = cvt_pk_bf16(v0[0], v0[1]); w.y = cvt_pk_bf16(v0[2], v0[3]); w.z = cvt_pk_bf16(v1[0], v1[1]); w.w = cvt_pk_bf16(v1[2], v1[3]);
                        if (MODE == 1) asm volatile("global_store_dwordx4 %0, %1, off sc1\n\ts_nop 1" :: "v"(dst), "v"(w) : "memory");
                        else *(u32x4*)dst = w;
                    }
                } else if (MODE == 2) {
#pragma unroll
                    for (int bj = 0; bj < 2; ++bj) {
                        const int hf = 2 * u.pn + bj;
                        f32x4 v0 = acc[ai][bj][m][0] * sc, v1 = acc[ai][bj][m][1] * sc;
                        float part = (v0[0] * v0[0] + v0[1] * v0[1]) + (v0[2] * v0[2] + v0[3] * v0[3]) + (v1[0] * v1[0] + v1[1] * v1[1]) + (v1[2] * v1[2] + v1[3] * v1[3]);
                        part += __shfl_xor(part, 16); part += __shfl_xor(part, 32);
                        u32x4 w; w.x = cvt_pk_bf16(v0[0], v0[1]); w.y = cvt_pk_bf16(v0[2], v0[3]); w.z = cvt_pk_bf16(v1[0], v1[1]); w.w = cvt_pk_bf16(v1[2], v1[3]);
                        if (hf < 3) { *(u32x4*)(O + (size_t)row * 384 + hf * 128 + wc * 32 + 8 * fq) = w; if (fq == 0) ssq_o1[(size_t)row * 16 + hf * 4 + wc] = part; }
                        else if (hf < 5) { *(u32x4*)(O2 + (size_t)row * 256 + (hf - 3) * 128 + wc * 32 + 8 * fq) = w; if (fq == 0) ssq_o2[(size_t)row * 16 + (hf - 3) * 4 + wc] = part; }
                        else if (wc < 2) { *(u32x4*)(O3 + (size_t)row * 64 + wc * 32 + 8 * fq) = w; }
                    }
                } else {
                    float part = 0.f;
#pragma unroll
                    for (int bj = 0; bj < 2; ++bj) {
                        const size_t off = (size_t)row * ldc + u.pn * BM + bj * HALF + wc * 32 + 8 * fq;
                        const u32x4 b = bj == 0 ? bw0 : bw1;
                        f32x4 b0, b1;
                        b0[0] = __uint_as_float(b.x << 16); b0[1] = __uint_as_float(b.x & 0xffff0000u); b0[2] = __uint_as_float(b.y << 16); b0[3] = __uint_as_float(b.y & 0xffff0000u);
                        b1[0] = __uint_as_float(b.z << 16); b1[1] = __uint_as_float(b.z & 0xffff0000u); b1[2] = __uint_as_float(b.w << 16); b1[3] = __uint_as_float(b.w & 0xffff0000u);
                        const f32x4 v0 = b0 + acc[ai][bj][m][0] * sc, v1 = b1 + acc[ai][bj][m][1] * sc;
                        if (out != nullptr) { *(f32x4*)(out + off) = v0; *(f32x4*)(out + off + 4) = v1; }
                        part += (v0[0] * v0[0] + v0[1] * v0[1]) + (v0[2] * v0[2] + v0[3] * v0[3]) + (v1[0] * v1[0] + v1[1] * v1[1]) + (v1[2] * v1[2] + v1[3] * v1[3]);
                        if (ssq_o1 != nullptr) {
                            u32x4 w; w.x = cvt_pk_bf16(v0[0], v0[1]); w.y = cvt_pk_bf16(v0[2], v0[3]); w.z = cvt_pk_bf16(v1[0], v1[1]); w.w = cvt_pk_bf16(v1[2], v1[3]);
                            *(u32x4*)(O + off) = w;
                        }
                    }
                    part += __shfl_xor(part, 16); part += __shfl_xor(part, 32);
                    if (fq == 0 && ssq_o1 != nullptr) ssq_o1[(size_t)row * 16 + u.pn * 4 + wc] = part;
                }
                asm volatile("" ::: "memory");
            }
        }
#undef EPI_LOADH
    }
};

template <class Epi, class Sched, bool ALIGN_EPI = false, bool SP2 = false>
__device__ __forceinline__ void gemm_phase(PG8_LAS unsigned char* lds, const Gemm g, const Sched& S, const Epi& E) {
    int tid_o = threadIdx.x; asm volatile("" : "+v"(tid_o));
    const int tid = tid_o, wid = __builtin_amdgcn_readfirstlane(tid >> 6), lane = tid & 63, wr = wid >> 2, wc = wid & 3, fr = lane & 15, fq = lane >> 4;
    const int K = g.K, nt = K / BK;
    unsigned voffA[2], voffB[2];
#pragma unroll
    for (int i = 0; i < 2; ++i) { int R, C; stage_rc(tid * 16 + i * 8192, R, C); const int Rb = Epi::PERM ? ((R & ~31) + perm32(R & 31)) : R;
        voffA[i] = (unsigned)(R * K + C) * 2u; voffB[i] = (unsigned)(Rb * K + C) * 2u; }
    const size_t kstep = (size_t)(BK * 2);
    const size_t hstep = (size_t)HALF * K * 2;
    const size_t tstep = 2 * hstep;
    const unsigned ldsw = (unsigned)wid * 1024u;
    const int aoff = lds_byte(wr * 64 + fr, fq * 8), boff = lds_byte(wc * 32 + fr, fq * 8);
#define PG8_SA(b, h) (((b) * 2 + (h)) * HTB)
#define PG8_SB(b, h) ((4 + (b) * 2 + (h)) * HTB)
#define PG8_STAGE(bufoff, gbase, voff) do { _Pragma("unroll") for (int _i = 0; _i < 2; ++_i) \
        __builtin_amdgcn_global_load_lds((const unsigned*)((const char*)(gbase) + (voff)[_i]), (PG8_LAS unsigned*)(lds + (bufoff) + ldsw + _i * 8192), 16, 0, 0); } while (0)
#define PG8_LDA(dst, b, h) do { _Pragma("unroll") for (int m = 0; m < 4; ++m) _Pragma("unroll") for (int k = 0; k < 2; ++k) dst[m][k] = *(const PG8_LAS bf16x8*)(lds + PG8_SA(b, h) + aoff + m * 2048 + k * 1024); } while (0)
#define PG8_LDB(dst, b, h) do { _Pragma("unroll") for (int n = 0; n < 2; ++n) _Pragma("unroll") for (int k = 0; k < 2; ++k) dst[n][k] = *(const PG8_LAS bf16x8*)(lds + PG8_SB(b, h) + boff + n * 2048 + k * 1024); } while (0)
#define PG8_MMA(ai, bj, At, Bt) do { __builtin_amdgcn_s_setprio(1); _Pragma("unroll") for (int m = 0; m < 4; ++m) _Pragma("unroll") for (int n = 0; n < 2; ++n) _Pragma("unroll") for (int k = 0; k < 2; ++k) \
        acc[ai][bj][m][n] = __builtin_amdgcn_mfma_f32_16x16x32_bf16(Bt[n][k], At[m][k], acc[ai][bj][m][n], 0, 0, 0); __builtin_amdgcn_s_setprio(0); } while (0)
#define PG8_WAIT_V(n) asm volatile("s_waitcnt vmcnt(" #n ")" ::: "memory")
#define PG8_WAIT_L(n) asm volatile("s_waitcnt lgkmcnt(" #n ")" ::: "memory")
#define PG8_BAR __builtin_amdgcn_s_barrier()
#define PG8_SCHED __builtin_amdgcn_sched_barrier(0)
    Unit cur, nxt; int ui = 0;
    if (!S.next(0, cur)) return;
    f32x4 acc[2][2][4][2];
#pragma unroll
    for (int a = 0; a < 2; ++a)
#pragma unroll
        for (int b = 0; b < 2; ++b)
#pragma unroll
            for (int m = 0; m < 4; ++m)
#pragma unroll
                for (int n = 0; n < 2; ++n) acc[a][b][m][n] = (f32x4){0.f, 0.f, 0.f, 0.f};
    bf16x8 At[4][2], B0[2][2], B1[2][2];
    const char* cA = (const char*)g.A + (size_t)cur.pm * tstep; const char* cB = (const char*)g.Bt + (size_t)cur.pn * tstep;
    S.a_ready(cur);
    if constexpr (SP2) {
        PG8_STAGE(PG8_SB(0, 0), cB, voffB); PG8_STAGE(PG8_SB(0, 1), cB + hstep, voffB); PG8_STAGE(PG8_SA(0, 0), cA, voffA); PG8_STAGE(PG8_SA(0, 1), cA + hstep, voffA);
        if (wr == 1) PG8_BAR;
        PG8_WAIT_V(2); PG8_BAR;
        PG8_STAGE(PG8_SB(1, 0), cB + kstep, voffB); PG8_STAGE(PG8_SA(1, 0), cA + kstep, voffA); PG8_STAGE(PG8_SB(1, 1), cB + hstep + kstep, voffB);
        PG8_WAIT_V(6); PG8_BAR;
    } else {
        PG8_STAGE(PG8_SB(0, 0), cB, voffB); PG8_STAGE(PG8_SA(0, 0), cA, voffA); PG8_STAGE(PG8_SB(0, 1), cB + hstep, voffB); PG8_STAGE(PG8_SA(0, 1), cA + hstep, voffA);
        if (wr == 1) PG8_BAR;
        PG8_WAIT_V(4); PG8_BAR;
        PG8_STAGE(PG8_SB(1, 0), cB + kstep, voffB); PG8_STAGE(PG8_SA(1, 0), cA + kstep, voffA); PG8_STAGE(PG8_SB(1, 1), cB + hstep + kstep, voffB);
        PG8_WAIT_V(6); PG8_BAR;
    }
    for (;;) {
        const bool has_next = S.next(ui + 1, nxt);
        const char* nA = has_next ? (const char*)g.A + (size_t)nxt.pm * tstep : cA; const char* nB = has_next ? (const char*)g.Bt + (size_t)nxt.pn * tstep : cB;
        for (int t = 0; t < nt; t += 2) {
            const bool last = (t == nt - 2);
            const char* a1 = cA + (size_t)(t + 1) * kstep;
            const char* a2 = last ? nA : cA + (size_t)(t + 2) * kstep; const char* b2 = last ? nB : cB + (size_t)(t + 2) * kstep;
            const char* a3 = a2 + kstep; const char* b3 = b2 + kstep;
            if (last && has_next) S.a_ready(nxt);
            if constexpr (SP2) {
            PG8_LDB(B0, 0, 0); PG8_LDB(B1, 0, 1); PG8_SCHED; PG8_LDA(At, 0, 0); PG8_STAGE(PG8_SA(1, 1), a1 + hstep, voffA);
            PG8_WAIT_V(8); PG8_WAIT_L(0); PG8_BAR; PG8_MMA(0, 0, At, B0); PG8_MMA(0, 1, At, B1); PG8_BAR; PG8_SCHED;
            PG8_LDA(At, 0, 1); PG8_STAGE(PG8_SB(0, 0), b2, voffB); PG8_STAGE(PG8_SB(0, 1), b2 + hstep, voffB); PG8_STAGE(PG8_SA(0, 0), a2, voffA);
            PG8_WAIT_V(8); PG8_WAIT_L(0); PG8_BAR; PG8_MMA(1, 0, At, B0); PG8_MMA(1, 1, At, B1); PG8_BAR; PG8_SCHED;
            PG8_LDB(B0, 1, 0); PG8_LDB(B1, 1, 1); PG8_SCHED; PG8_LDA(At, 1, 0); PG8_STAGE(PG8_SA(0, 1), a2 + hstep, voffA);
            PG8_WAIT_V(8); PG8_WAIT_L(0); PG8_BAR; PG8_MMA(0, 0, At, B0); PG8_MMA(0, 1, At, B1); PG8_BAR; PG8_SCHED;
            PG8_LDA(At, 1, 1); PG8_STAGE(PG8_SB(1, 0), b3, voffB); PG8_STAGE(PG8_SB(1, 1), b3 + hstep, voffB); PG8_STAGE(PG8_SA(1, 0), a3, voffA);
            PG8_WAIT_V(8); PG8_WAIT_L(0); PG8_BAR; PG8_MMA(1, 0, At, B0); PG8_MMA(1, 1, At, B1); PG8_BAR; PG8_SCHED;
            } else {
            PG8_LDB(B0, 0, 0); PG8_SCHED; PG8_LDA(At, 0, 0); PG8_STAGE(PG8_SA(1, 1), a1 + hstep, voffA);
            PG8_WAIT_L(8); PG8_BAR; PG8_WAIT_L(0); PG8_MMA(0, 0, At, B0); PG8_BAR; PG8_SCHED;
            PG8_LDB(B1, 0, 1); PG8_STAGE(PG8_SB(0, 0), b2, voffB);
            PG8_BAR; PG8_WAIT_L(0); PG8_MMA(0, 1, At, B1); PG8_BAR;
            PG8_LDA(At, 0, 1); PG8_STAGE(PG8_SA(0, 0), a2, voffA);
            PG8_BAR; PG8_WAIT_L(0); PG8_MMA(1, 0, At, B0); PG8_BAR; PG8_SCHED;
            PG8_STAGE(PG8_SB(0, 1), b2 + hstep, voffB);
            PG8_WAIT_V(6); PG8_BAR; PG8_MMA(1, 1, At, B1); PG8_BAR;
            PG8_LDB(B0, 1, 0); PG8_SCHED; PG8_LDA(At, 1, 0); PG8_STAGE(PG8_SA(0, 1), a2 + hstep, voffA);
            PG8_WAIT_L(8); PG8_BAR; PG8_WAIT_L(0); PG8_MMA(0, 0, At, B0); PG8_BAR; PG8_SCHED;
            PG8_LDB(B1, 1, 1); PG8_STAGE(PG8_SB(1, 0), b3, voffB);
            PG8_BAR; PG8_WAIT_L(0); PG8_MMA(0, 1, At, B1); PG8_BAR;
            PG8_LDA(At, 1, 1); PG8_STAGE(PG8_SA(1, 0), a3, voffA);
            PG8_BAR; PG8_WAIT_L(0); PG8_MMA(1, 0, At, B0); PG8_BAR; PG8_SCHED;
            PG8_STAGE(PG8_SB(1, 1), b3 + hstep, voffB);
            PG8_WAIT_V(6); PG8_BAR; PG8_MMA(1, 1, At, B1); PG8_BAR;
            }
        }
        if constexpr (ALIGN_EPI) { if (wr == 0) PG8_BAR; }
        if constexpr (!Epi::AFTER_DRAIN) { E(acc, cur, wr, wc, fr, fq); S.done(cur); }
        if (!has_next) break;
#pragma unroll
        for (int a = 0; a < 2; ++a)
#pragma unroll
            for (int b = 0; b < 2; ++b)
#pragma unroll
                for (int m = 0; m < 4; ++m)
#pragma unroll
                    for (int n = 0; n < 2; ++n) acc[a][b][m][n] = (f32x4){0.f, 0.f, 0.f, 0.f};
        cur = nxt; cA = nA; cB = nB; ++ui;
        if constexpr (ALIGN_EPI) { if (wr == 1) PG8_BAR; }
    }
    PG8_WAIT_V(0);
    if constexpr (!ALIGN_EPI) { if (wr == 0) PG8_BAR; }
    PG8_BAR;
    if constexpr (Epi::AFTER_DRAIN) { E.fused(acc, cur, wr, wc, fr, fq, lds, wid, lane); S.done(cur); }
#undef PG8_SA
#undef PG8_SB
#undef PG8_STAGE
#undef PG8_LDA
#undef PG8_LDB
#undef PG8_MMA
#undef PG8_WAIT_V
#undef PG8_WAIT_L
#undef PG8_BAR
#undef PG8_SCHED
}
}

constexpr int BATCH = 16, SEQ = 2048, DM = 1024, TOK = BATCH * SEQ, NH = 8, DFF = 4096;
#define LAS __attribute__((address_space(3)))
typedef LAS unsigned char* lptr;
typedef unsigned short bf16;
typedef short bf16x8 __attribute__((ext_vector_type(8)));
typedef float f32x4 __attribute__((ext_vector_type(4)));
typedef float f32x16 __attribute__((ext_vector_type(16)));
typedef unsigned u32x4 __attribute__((ext_vector_type(4)));
typedef unsigned u32x2 __attribute__((ext_vector_type(2)));
typedef int i32x4 __attribute__((ext_vector_type(4)));
typedef short s16x4 __attribute__((ext_vector_type(4)));
using pg8::cvt_pk_bf16;
__device__ __forceinline__ float bf2f(unsigned short v) { return __uint_as_float(((unsigned)v) << 16); }
__device__ __forceinline__ float bflo(unsigned w) { return __uint_as_float(w << 16); }
__device__ __forceinline__ float bfhi(unsigned w) { return __uint_as_float(w & 0xffff0000u); }

namespace att {
constexpr int VROW = 320;
template <int DQK> struct Lay {
    static constexpr int KROW = DQK * 2 + 16, KBUF = 64 * KROW, VBUF = 64 * VROW;
    static constexpr int OFF_K = 0, OFF_V = 2 * KBUF, OFF_POS = OFF_V + 2 * VBUF, OFF_LUT = OFF_POS + 512, OFF_KM = OFF_LUT + 4096, END = OFF_KM + 4096;
};
struct Args {
    const bf16* Q; int q_pitch;
    const bf16* K1; int k1_pitch;
    const bf16* K2;
    const bf16* V; int v_pitch;
    bf16* O;
    const int* pos; const float* lut; const float* kmean;
    const float* gq_n; const float* gq_r; const float* cosT; const float* sinT; float qscale;
    const float* gk_n; const float* gk_r; const float* relb;
};
#define MFMA32(a, b, c) __builtin_amdgcn_mfma_f32_32x32x16_bf16((a), (b), (c), 0, 0, 0)

template <int DQK, bool MOBA>
__device__ __forceinline__ void attn_unit(const Args& A, int b, int h, int qb, lptr lds) {
    using L = Lay<DQK>;
    constexpr int NS = DQK / 16;
    constexpr float NEG = -1.0e30f;
    int tid_o = threadIdx.x; asm volatile("" : "+v"(tid_o));
    const int tid = tid_o, lane = tid & 63, r32 = lane & 31, hi = lane >> 5;
    const int wid = __builtin_amdgcn_readfirstlane(tid >> 6);
    const int tb = b * SEQ, q0 = qb * 256, own = qb, bh = b * NH + h;
    const int qrow = tb + q0 + wid * 32 + r32;
    const int qrel = wid * 32 + r32;
    __syncthreads();
    bf16x8 qf[NS];
    {
        const bf16* qp = A.Q + (size_t)qrow * A.q_pitch + h * DQK + 8 * hi;
#pragma unroll
        for (int s = 0; s < NS; ++s) qf[s] = *(const bf16x8*)(qp + 16 * s);
    }
    {
        float ssn = 0.f;
#pragma unroll
        for (int s = 0; s < 8; ++s)
#pragma unroll
            for (int e = 0; e < 8; ++e) { const float f = bf2f((unsigned short)qf[s][e]); ssn += f * f; }
        ssn += __shfl_xor(ssn, 32);
        const float scn = __builtin_amdgcn_rsqf(ssn * (1.0f / 128.0f) + 1e-6f) * A.qscale;
#pragma unroll
        for (int s = 0; s < 8; ++s) {
            const f32x4 g0 = *(const f32x4*)(A.gq_n + 16 * s + 8 * hi), g1 = *(const f32x4*)(A.gq_n + 16 * s + 8 * hi + 4);
            u32x4 w;
            w.x = cvt_pk_bf16(bf2f((unsigned short)qf[s][0]) * scn * g0[0], bf2f((unsigned short)qf[s][1]) * scn * g0[1]);
            w.y = cvt_pk_bf16(bf2f((unsigned short)qf[s][2]) * scn * g0[2], bf2f((unsigned short)qf[s][3]) * scn * g0[3]);
            w.z = cvt_pk_bf16(bf2f((unsigned short)qf[s][4]) * scn * g1[0], bf2f((unsigned short)qf[s][5]) * scn * g1[1]);
            w.w = cvt_pk_bf16(bf2f((unsigned short)qf[s][6]) * scn * g1[2], bf2f((unsigned short)qf[s][7]) * scn * g1[3]);
            qf[s] = __builtin_bit_cast(bf16x8, w);
        }
        if (DQK == 192) {
            float ssr = 0.f;
#pragma unroll
            for (int s = 8; s < NS; ++s)
#pragma unroll
                for (int e = 0; e < 8; ++e) { const float f = bf2f((unsigned short)qf[s][e]); ssr += f * f; }
            ssr += __shfl_xor(ssr, 32);
            const float scr = __builtin_amdgcn_rsqf(ssr * (1.0f / 64.0f) + 1e-6f);
#pragma unroll
            for (int sp = 0; sp < 2; ++sp) {
                const int i0 = 16 * sp + 8 * hi;
                float o1[8], o2[8];
                const f32x4 ga0 = *(const f32x4*)(A.gq_r + i0), ga1 = *(const f32x4*)(A.gq_r + i0 + 4), gb0 = *(const f32x4*)(A.gq_r + 32 + i0), gb1 = *(const f32x4*)(A.gq_r + 32 + i0 + 4);
                const f32x4 cc0 = *(const f32x4*)(A.cosT + (size_t)qrow * 32 + i0), cc1 = *(const f32x4*)(A.cosT + (size_t)qrow * 32 + i0 + 4);
                const f32x4 ss0 = *(const f32x4*)(A.sinT + (size_t)qrow * 32 + i0), ss1 = *(const f32x4*)(A.sinT + (size_t)qrow * 32 + i0 + 4);
#pragma unroll
                for (int e = 0; e < 8; ++e) {
                    const float x1 = bf2f((unsigned short)qf[(NS == 12 ? 8 : 0) + sp][e]) * scr * (e < 4 ? ga0[e & 3] : ga1[e & 3]);
                    const float x2 = bf2f((unsigned short)qf[(NS == 12 ? 10 : 0) + sp][e]) * scr * (e < 4 ? gb0[e & 3] : gb1[e & 3]);
                    const float c = e < 4 ? cc0[e & 3] : cc1[e & 3], sn = e < 4 ? ss0[e & 3] : ss1[e & 3];
                    o1[e] = (x1 * c - x2 * sn) * A.qscale; o2[e] = (x2 * c + x1 * sn) * A.qscale;
                }
                u32x4 w1, w2;
                w1.x = cvt_pk_bf16(o1[0], o1[1]); w1.y = cvt_pk_bf16(o1[2], o1[3]); w1.z = cvt_pk_bf16(o1[4], o1[5]); w1.w = cvt_pk_bf16(o1[6], o1[7]);
                w2.x = cvt_pk_bf16(o2[0], o2[1]); w2.y = cvt_pk_bf16(o2[2], o2[3]); w2.z = cvt_pk_bf16(o2[4], o2[5]); w2.w = cvt_pk_bf16(o2[6], o2[7]);
                qf[(NS == 12 ? 8 : 0) + sp] = __builtin_bit_cast(bf16x8, w1); qf[(NS == 12 ? 10 : 0) + sp] = __builtin_bit_cast(bf16x8, w2);
            }
        }
    }
    unsigned sel = 0xffu; int pq = 0;
    LAS float* lut = (LAS float*)(lds + L::OFF_LUT);
    if (MOBA) {
        LAS float* km = (LAS float*)(lds + L::OFF_KM);
        lut[tid] = A.lut[h * 1024 + tid]; lut[tid + 512] = A.lut[h * 1024 + tid + 512];
        km[tid] = A.kmean[(size_t)bh * 1024 + tid]; km[tid + 512] = A.kmean[(size_t)bh * 1024 + tid + 512];
        pq = A.pos[qrow];
        __syncthreads();
        if (own <= 3) sel = (1u << own) - 1u;
        else {
            float g[7];
#pragma unroll
            for (int j = 0; j < 7; ++j) {
                float a = 0.f;
                if (j < own) {
#pragma unroll
                    for (int s = 0; s < NS; ++s) {
                        const f32x4 k0 = *(const LAS f32x4*)(km + j * 128 + 16 * s + 8 * hi), k1 = *(const LAS f32x4*)(km + j * 128 + 16 * s + 8 * hi + 4);
                        a += bf2f((unsigned short)qf[s][0]) * k0[0] + bf2f((unsigned short)qf[s][1]) * k0[1] + bf2f((unsigned short)qf[s][2]) * k0[2] + bf2f((unsigned short)qf[s][3]) * k0[3];
                        a += bf2f((unsigned short)qf[s][4]) * k1[0] + bf2f((unsigned short)qf[s][5]) * k1[1] + bf2f((unsigned short)qf[s][6]) * k1[2] + bf2f((unsigned short)qf[s][7]) * k1[3];
                    }
                }
                a += __shfl_xor(a, 32);
                g[j] = a;
            }
            sel = 0u;
#pragma unroll
            for (int rnd = 0; rnd < 3; ++rnd) {
                float best = -INFINITY; int bi = -1;
#pragma unroll
                for (int j = 0; j < 7; ++j) { const bool c = (j < own) && !((sel >> j) & 1u) && (g[j] > best); best = c ? g[j] : best; bi = c ? j : bi; }
                if (bi >= 0) sel |= 1u << bi;
            }
        }
    }
    float negm;
    {
        float qss = 0.f;
#pragma unroll
        for (int s = 0; s < NS; ++s)
#pragma unroll
            for (int e = 0; e < 8; ++e) { const float f = bf2f((unsigned short)qf[s][e]); qss += f * f; }
        qss += __shfl_xor(qss, 32);
        float gmx = fmaxf(fabsf(A.gk_n[lane]), fabsf(A.gk_n[lane + 64]));
        float grx = (DQK == 192) ? fabsf(A.gk_r[lane]) : 0.f;
        float bmx = (MOBA && lane < 32) ? fabsf(A.relb[lane * 8 + h]) * 1.4426950408889634f : 0.f;
#pragma unroll
        for (int o_ = 1; o_ < 64; o_ <<= 1) { gmx = fmaxf(gmx, __shfl_xor(gmx, o_)); grx = fmaxf(grx, __shfl_xor(grx, o_)); bmx = fmaxf(bmx, __shfl_xor(bmx, o_)); }
        negm = -(sqrtf(qss * (128.0f * gmx * gmx + 64.0f * grx * grx)) * 1.01f + bmx + 0.01f);
    }
    const int NT = 4 * (own + 1);
    u32x4 kr0, kr1, kr2, vr0, vr1; int pkr = 0;
    kr2 = (u32x4){0u, 0u, 0u, 0u};
#define ATT_KEY0(t) ((((t) < 4) ? own * 4 + (t) : (t) - 4) * 64)
#define ATT_LOAD(t) do { const int key0_ = ATT_KEY0(t); \
        const bf16* kp_ = A.K1 + (size_t)(tb + key0_) * A.k1_pitch + h * 128; \
        kr0 = *(const u32x4*)(kp_ + (size_t)(tid >> 4) * A.k1_pitch + (tid & 15) * 8); \
        kr1 = *(const u32x4*)(kp_ + (size_t)((tid >> 4) + 32) * A.k1_pitch + (tid & 15) * 8); \
        if (DQK == 192) kr2 = *(const u32x4*)(A.K2 + (size_t)(tb + key0_ + (tid >> 3)) * 64 + (tid & 7) * 8); \
        const bf16* vp_ = A.V + (size_t)(tb + key0_) * A.v_pitch + h * 128; \
        vr0 = *(const u32x4*)(vp_ + (size_t)(tid >> 4) * A.v_pitch + (tid & 15) * 8); \
        vr1 = *(const u32x4*)(vp_ + (size_t)((tid >> 4) + 32) * A.v_pitch + (tid & 15) * 8); \
        if (MOBA && tid < 64) pkr = A.pos[tb + key0_ + tid]; } while (0)
#define ATT_WRITE(buf) do { lptr kb_ = lds + L::OFF_K + (buf) * L::KBUF; lptr vb_ = lds + L::OFF_V + (buf) * L::VBUF; \
        *(LAS u32x4*)(kb_ + (tid >> 4) * L::KROW + (tid & 15) * 16) = kr0; \
        *(LAS u32x4*)(kb_ + ((tid >> 4) + 32) * L::KROW + (tid & 15) * 16) = kr1; \
        if (DQK == 192) *(LAS u32x4*)(kb_ + (tid >> 3) * L::KROW + 256 + (tid & 7) * 16) = kr2; \
        *(LAS u32x4*)(vb_ + (tid >> 4) * VROW + (tid & 15) * 16) = vr0; \
        *(LAS u32x4*)(vb_ + ((tid >> 4) + 32) * VROW + (tid & 15) * 16) = vr1; \
        if (MOBA && tid < 64) ((LAS int*)(lds + L::OFF_POS + (buf) * 256))[tid] = pkr; } while (0)

    f32x16 o[4];
#pragma unroll
    for (int d = 0; d < 4; ++d)
#pragma unroll
        for (int r = 0; r < 16; ++r) o[d][r] = 0.f;
    float lrow = 0.f;

    ATT_LOAD(0); ATT_WRITE(0);
    if (NT > 1) ATT_LOAD(1);
    __syncthreads();
    for (int t = 0; t < NT; ++t) {
        const int buf = t & 1;
        if (t + 1 < NT) { ATT_WRITE(buf ^ 1); if (t + 2 < NT) ATT_LOAD(t + 2); }
        const int tt = t & 3; const bool diag = t < 4; const int blk = diag ? own : ((t - 4) >> 2);
        const bool lsel = diag || ((sel >> blk) & 1u);
        bool act;
        if (diag) act = (64 * tt < 32 * (wid + 1));
        else act = MOBA ? (__ballot(lsel) != 0ull) : true;
        if (act) {
            lptr kb = lds + L::OFF_K + buf * L::KBUF + r32 * L::KROW + 16 * hi;
            f32x16 s0, s1;
#pragma unroll
            for (int r = 0; r < 16; ++r) { s0[r] = negm; s1[r] = negm; }
            {
                bf16x8 ka[2][2], kc[2][2];
#pragma unroll
                for (int i = 0; i < 2; ++i) { ka[0][i] = *(const LAS bf16x8*)(kb + 32 * i); kc[0][i] = *(const LAS bf16x8*)(kb + 32 * L::KROW + 32 * i); }
                __builtin_amdgcn_sched_barrier(0);
#pragma unroll
                for (int sb = 0; sb < NS; sb += 2) {
                    const int cur = (sb >> 1) & 1, nxt = cur ^ 1;
                    if (sb + 2 < NS) {
#pragma unroll
                        for (int i = 0; i < 2; ++i) { ka[nxt][i] = *(const LAS bf16x8*)(kb + 32 * (sb + 2 + i)); kc[nxt][i] = *(const LAS bf16x8*)(kb + 32 * L::KROW + 32 * (sb + 2 + i)); }
                    }
                    __builtin_amdgcn_sched_barrier(0);
                    __builtin_amdgcn_s_setprio(1);
#pragma unroll
                    for (int i = 0; i < 2; ++i) { s0 = MFMA32(ka[cur][i], qf[sb + i], s0); s1 = MFMA32(kc[cur][i], qf[sb + i], s1); }
                    __builtin_amdgcn_s_setprio(0);
                    __builtin_amdgcn_sched_barrier(0);
                }
            }
            if (MOBA) {
                const LAS int* pp = (const LAS int*)(lds + L::OFF_POS + buf * 256);
#pragma unroll
                for (int a = 0; a < 4; ++a) {
                    const i32x4 p0 = *(const LAS i32x4*)(pp + 8 * a + 4 * hi), p1 = *(const LAS i32x4*)(pp + 32 + 8 * a + 4 * hi);
                    const int pa[4] = {p0.x, p0.y, p0.z, p0.w}, pb[4] = {p1.x, p1.y, p1.z, p1.w};
#pragma unroll
                    for (int e = 0; e < 4; ++e) {
                        int d0 = pq - pa[e]; d0 = d0 < 0 ? 0 : (d0 > 1023 ? 1023 : d0);
                        int d1 = pq - pb[e]; d1 = d1 < 0 ? 0 : (d1 > 1023 ? 1023 : d1);
                        s0[4 * a + e] += lut[d0]; s1[4 * a + e] += lut[d1];
                    }
                }
                if (!lsel) {
#pragma unroll
                    for (int r = 0; r < 16; ++r) { s0[r] = NEG; s1[r] = NEG; }
                }
            }
            if (diag) {
#pragma unroll
                for (int r = 0; r < 16; ++r) {
                    const int kl = 64 * tt + (r & 3) + 8 * (r >> 2) + 4 * hi;
                    if (kl > qrel) s0[r] = NEG;
                    if (kl + 32 > qrel) s1[r] = NEG;
                }
            }
            float ls = 0.f;
#pragma unroll
            for (int r = 0; r < 16; ++r) { s0[r] = __builtin_amdgcn_exp2f(s0[r]); s1[r] = __builtin_amdgcn_exp2f(s1[r]); ls += s0[r] + s1[r]; }
            lrow += ls;
            bf16x8 pb[4];
#pragma unroll
            for (int g = 0; g < 2; ++g) {
                u32x4 w0, w1;
                w0.x = cvt_pk_bf16(s0[8 * g + 0], s0[8 * g + 1]); w0.y = cvt_pk_bf16(s0[8 * g + 2], s0[8 * g + 3]); w0.z = cvt_pk_bf16(s0[8 * g + 4], s0[8 * g + 5]); w0.w = cvt_pk_bf16(s0[8 * g + 6], s0[8 * g + 7]);
                w1.x = cvt_pk_bf16(s1[8 * g + 0], s1[8 * g + 1]); w1.y = cvt_pk_bf16(s1[8 * g + 2], s1[8 * g + 3]); w1.z = cvt_pk_bf16(s1[8 * g + 4], s1[8 * g + 5]); w1.w = cvt_pk_bf16(s1[8 * g + 6], s1[8 * g + 7]);
                pb[g] = __builtin_bit_cast(bf16x8, w0); pb[2 + g] = __builtin_bit_cast(bf16x8, w1);
            }
            lptr vb = lds + L::OFF_V + buf * L::VBUF + (4 * hi + ((lane & 15) >> 2)) * VROW + ((lane >> 4) & 1) * 32 + (lane & 3) * 8;
#pragma unroll
            for (int d = 0; d < 4; ++d) {
                s16x4 lo[4], hi4[4];
#pragma unroll
                for (int g = 0; g < 4; ++g) {
                    lo[g] = __builtin_bit_cast(s16x4, __builtin_amdgcn_ds_read_tr16_b64_v4i16((LAS s16x4*)(vb + (16 * g) * VROW + d * 64)));
                    hi4[g] = __builtin_bit_cast(s16x4, __builtin_amdgcn_ds_read_tr16_b64_v4i16((LAS s16x4*)(vb + (16 * g + 8) * VROW + d * 64)));
                }
                __builtin_amdgcn_sched_barrier(0);
                __builtin_amdgcn_s_setprio(1);
#pragma unroll
                for (int g = 0; g < 4; ++g) {
                    const bf16x8 av = __builtin_shufflevector(lo[g], hi4[g], 0, 1, 2, 3, 4, 5, 6, 7);
                    o[d] = MFMA32(av, pb[g], o[d]);
                }
                __builtin_amdgcn_s_setprio(0);
            }
        }
        __syncthreads();
    }
    lrow += __shfl_xor(lrow, 32);
    const float inv = 1.0f / lrow;
    bf16* op = A.O + (size_t)qrow * 1024 + h * 128 + 4 * hi;
#pragma unroll
    for (int d = 0; d < 4; ++d)
#pragma unroll
        for (int a = 0; a < 4; ++a) {
            u32x2 w; w.x = cvt_pk_bf16(o[d][4 * a] * inv, o[d][4 * a + 1] * inv); w.y = cvt_pk_bf16(o[d][4 * a + 2] * inv, o[d][4 * a + 3] * inv);
            *(u32x2*)(op + 32 * d + 8 * a) = w;
        }
#undef ATT_KEY0
#undef ATT_LOAD
#undef ATT_WRITE
}

template <int DQK, bool MOBA>
__device__ __forceinline__ void attn_phase(const Args& A, lptr lds, int vcu, int G) {
    for (int v = vcu; v < 256; v += G) {
        const int x = v >> 5, c = v & 31, gq = c >> 3, k = c & 7;
#pragma unroll 1
        for (int r = 0; r < 4; ++r) {
            const int bh = x * 16 + r * 4 + gq;
            const int k2 = (k + 4) & 7;
            const int qb = (r == 0) ? k : (r == 1) ? 7 - k : (r == 2) ? k2 : 7 - k2;
            attn_unit<DQK, MOBA>(A, bh / NH, bh % NH, qb, lds);
        }
    }
}
}

constexpr size_t MiB = 1u << 20;
constexpr size_t WS_SSQ = 500 * MiB;
constexpr int SSQ_ATTN = 0, SSQ_MLP = 1, SSQ_CQ = 2, SSQ_CKV = 3, SSQ_N = 4;
constexpr size_t WS_COS = 2 * MiB, WS_SIN = 6 * MiB, WS_LUT = 10 * MiB, WS_KMEAN = 10 * MiB + 512 * 1024;
constexpr size_t WS_CTL = 11 * MiB, CTL_BYTES = 65536;
constexpr size_t WS_W = 12 * MiB;
constexpr size_t W_MLA_IN = 0, W_MLA_UQ = W_MLA_IN + (size_t)768 * 1024 * 2, W_MLA_UKV = W_MLA_UQ + (size_t)1536 * 384 * 2, W_MLA_O = W_MLA_UKV + (size_t)2048 * 256 * 2, W_MLA_SZ = W_MLA_O + (size_t)1024 * 1024 * 2;
constexpr size_t W_MOBA_QKV = 0, W_MOBA_O = (size_t)3072 * 1024 * 2, W_MOBA_SZ = W_MOBA_O + (size_t)1024 * 1024 * 2;
constexpr size_t W_MLP_IN = 0, W_MLP_OUT = (size_t)4096 * 1024 * 2, W_MLP_SZ = 2 * W_MLP_OUT;
constexpr size_t WS_WMLA = WS_W, WS_WMOBA = WS_WMLA + 2 * W_MLA_SZ, WS_WMLP = WS_WMOBA + 2 * W_MOBA_SZ, WS_WEND = WS_WMLP + 4 * W_MLP_SZ;
constexpr size_t WS_XB = 104 * MiB;
constexpr size_t WS_BIG = 168 * MiB;
constexpr size_t WS_H = WS_BIG;
constexpr size_t WS_Q = WS_BIG, WS_KN = WS_BIG + 96 * MiB, WS_VRAW = WS_BIG + 160 * MiB, WS_VT = WS_BIG + 224 * MiB, WS_O_MLA = WS_VT, WS_KPE = WS_BIG + 288 * MiB, WS_CQ = WS_BIG + 292 * MiB, WS_CKV = WS_BIG + 316 * MiB;
constexpr size_t WS_QKV = WS_BIG, WS_VT2 = WS_BIG + 192 * MiB, WS_O_MOBA = WS_BIG + 256 * MiB;
constexpr size_t WS_END = 512 * MiB;
static_assert(WS_WEND <= WS_XB && WS_CKV + 16 * MiB <= WS_SSQ && WS_O_MOBA + 64 * MiB <= WS_SSQ && WS_SSQ + 8 * MiB <= WS_END && WS_CKV + 16 * MiB <= WS_END && WS_O_MOBA + 64 * MiB <= WS_END && WS_H + 256 * MiB <= WS_END, "ws map");

constexpr int LDS_BYTES = 147456;
constexpr int NWAVES = 8;

struct KArgs {
    const float* x; const int* pos; const float* relb; const float* attn_norm; const float* mlp_norm;
    const float* mla_w_in; const float* mla_qa; const float* mla_kva; const float* mla_w_uq; const float* mla_w_ukv;
    const float* mla_qn; const float* mla_qr; const float* mla_kn; const float* mla_kr; const float* mla_w_o;
    const float* moba_w_qkv; const float* moba_qn; const float* moba_kn; const float* moba_w_o;
    const float* mlp_w_in; const float* mlp_w_out;
    float* out; unsigned char* ws;
    int use_cg_sync; int pad;
};

__device__ __forceinline__ float wave_sum(float v) {
#pragma unroll
    for (int o = 1; o < 64; o <<= 1) v += __shfl_xor(v, o);
    return v;
}

__device__ __forceinline__ void transpose_item(const float* W, const float* gain, int K, int N, bf16* WT, LAS float* scr, int item, int lane) {
    const int nblk = N / 32, kb = item / nblk, nb = item % nblk, k0 = 64 * kb, n0 = 32 * nb;
    float wv[32];
#pragma unroll
    for (int i = 0; i < 32; ++i) { const int kk = 2 * i + (lane >> 5); wv[i] = __builtin_nontemporal_load(W + (size_t)(k0 + kk) * N + n0 + (lane & 31)); }
#pragma unroll
    for (int i = 0; i < 32; ++i) { const int kk = 2 * i + (lane >> 5); const float g = gain ? gain[k0 + kk] : 1.f; scr[kk * 33 + (lane & 31)] = g * wv[i]; }
    asm volatile("s_waitcnt lgkmcnt(0)" ::: "memory");
    const int c = lane & 7;
#pragma unroll
    for (int j = 0; j < 4; ++j) { const int n = (lane >> 3) + 8 * j; const LAS float* s = scr + (8 * c) * 33 + n;
        u32x4 o; o.x = cvt_pk_bf16(s[0 * 33], s[1 * 33]); o.y = cvt_pk_bf16(s[2 * 33], s[3 * 33]); o.z = cvt_pk_bf16(s[4 * 33], s[5 * 33]); o.w = cvt_pk_bf16(s[6 * 33], s[7 * 33]);
        asm volatile("global_store_dwordx4 %0, %1, off sc1\n\ts_nop 1" :: "v"(WT + (size_t)(n0 + n) * K + k0 + 8 * c), "v"(o) : "memory"); }
    asm volatile("s_waitcnt lgkmcnt(0)" ::: "memory");
}

__device__ __forceinline__ void unpack8(const u32x4 v, float (&f)[8]) {
    f[0] = bflo(v.x); f[1] = bfhi(v.x); f[2] = bflo(v.y); f[3] = bfhi(v.y); f[4] = bflo(v.z); f[5] = bfhi(v.z); f[6] = bflo(v.w); f[7] = bfhi(v.w);
}
__device__ __forceinline__ u32x4 pack8(const float (&f)[8]) {
    u32x4 w; w.x = cvt_pk_bf16(f[0], f[1]); w.y = cvt_pk_bf16(f[2], f[3]); w.z = cvt_pk_bf16(f[4], f[5]); w.w = cvt_pk_bf16(f[6], f[7]); return w;
}

#define XB_TMO      128
#define XB_XCNT(j)  (256  + 64 * (j))
#define XB_XSUB(j)  (1280 + 64 * (j))
#define XB_XGEN(j)  (2304 + 64 * (j))
#define XB_TOP      3328
#define XB_TOPGEN   3392
#define XCD_BAR_WORDS 3456
#define XB_SPIN_CAP (1u << 18)

__device__ __forceinline__ unsigned xb_ld(unsigned* p)              { return __hip_atomic_load(p, __ATOMIC_RELAXED, __HIP_MEMORY_SCOPE_AGENT); }
__device__ __forceinline__ unsigned xb_add(unsigned* p, unsigned v) { return __hip_atomic_fetch_add(p, v, __ATOMIC_RELAXED, __HIP_MEMORY_SCOPE_AGENT); }
__device__ __forceinline__ unsigned xb_xcc_id() { return (unsigned)__builtin_amdgcn_s_getreg((3 << 11) | 20) & 0xFu; }
#define XB_SPIN(cond, bar) do { unsigned _sp = 0; while (cond) { __builtin_amdgcn_s_sleep(1); \
    if ((++_sp & 255u) == 0u) { if (xb_ld(&(bar)[XB_TMO])) break; if (_sp > XB_SPIN_CAP) { atomicAdd(&(bar)[XB_TMO], 1u); break; } } } } while (0)

struct XcdBarrier {
    unsigned* bar; unsigned x;
    volatile LAS unsigned* st;
};

__device__ __forceinline__ XcdBarrier xcd_barrier_post(unsigned* bar, volatile LAS unsigned* st) {
    XcdBarrier b; b.bar = bar; b.x = xb_xcc_id(); b.st = st;
    if (threadIdx.x == 0) (void)xb_add(&bar[XB_XCNT(b.x)], 1u);
    return b;
}
__device__ __forceinline__ void xcd_barrier_complete(unsigned* bar, unsigned x, unsigned& nloc, unsigned& nx) {
    const unsigned G = gridDim.x * gridDim.y * gridDim.z;
    unsigned sum, cnt, mine, sp = 0u;
    for (;;) {
        sum = 0u; cnt = 0u; mine = 0u;
#pragma unroll
        for (unsigned j = 0; j < 16; ++j) { const unsigned c = xb_ld(&bar[XB_XCNT(j)]); sum += c; cnt += (c > 0u) ? 1u : 0u; mine = (j == x) ? c : mine; }
        if (sum == G) break;
        __builtin_amdgcn_s_sleep(1);
        if ((++sp & 255u) == 0u) { if (xb_ld(&bar[XB_TMO])) break; if (sp > XB_SPIN_CAP) { atomicAdd(&bar[XB_TMO], 1u); break; } }
    }
    nloc = mine > 0u ? mine : 1u; nx = cnt > 0u ? cnt : 1u;
}

__device__ __forceinline__ void xcd_barrier(const XcdBarrier& b) {
    asm volatile("s_waitcnt vmcnt(0)" ::: "memory");
    __syncthreads();
    if (threadIdx.x == 0) {
        unsigned* bar = b.bar;
        __builtin_amdgcn_s_waitcnt(0);
        unsigned nloc = b.st[0], nx = b.st[1];
        if (nloc == 0u) { xcd_barrier_complete(bar, b.x, nloc, nx); b.st[0] = nloc; b.st[1] = nx; }
        const unsigned old = xb_add(&bar[XB_XSUB(b.x)], 1u);
        const unsigned gen = old / nloc;
        if (old + 1u == (gen + 1u) * nloc) {
            __builtin_amdgcn_fence(__ATOMIC_RELEASE, "agent");
            asm volatile("s_waitcnt vmcnt(0)" ::: "memory");
            const unsigned og = xb_add(&bar[XB_TOP], 1u);
            const unsigned tg = og / nx;
            if (og + 1u == (tg + 1u) * nx) xb_add(&bar[XB_TOPGEN], 1u);
            else XB_SPIN(xb_ld(&bar[XB_TOPGEN]) == tg, bar);
            __builtin_amdgcn_fence(__ATOMIC_ACQUIRE, "agent");
            xb_add(&bar[XB_XGEN(b.x)], 1u);
            asm volatile("s_waitcnt vmcnt(0)" ::: "memory");
        } else {
            XB_SPIN(xb_ld(&bar[XB_XGEN(b.x)]) == gen, bar);
            __builtin_amdgcn_fence(__ATOMIC_ACQUIRE, "agent");
            asm volatile("s_waitcnt vmcnt(0)" ::: "memory");
        }
    }
    __syncthreads();
}

__global__ void __launch_bounds__(512) fwd_megakernel(KArgs a) {
    extern __shared__ __attribute__((aligned(16))) unsigned char lds_raw[];
    cg::grid_group grid = cg::this_grid();
    lptr lds = (lptr)lds_raw;
    const int wave = __builtin_amdgcn_readfirstlane(threadIdx.x >> 6);
    const int G = gridDim.x, bx = blockIdx.x;
    volatile LAS unsigned* MISC = (volatile LAS unsigned*)(lds + 131072);
    if (threadIdx.x < 16) MISC[threadIdx.x] = 0u;
    __syncthreads();
    XcdBarrier xbar = xcd_barrier_post((unsigned*)(a.ws + WS_CTL), MISC + 8);
#define GRID_SYNC() do { xcd_barrier(xbar); } while (0)
#define OPAQUE_TID() int tid = threadIdx.x; asm volatile("" : "+v"(tid)); const int lane = tid & 63
    const int vcu = (G % 8 == 0) ? (bx % 8) * (G / 8) + bx / 8 : bx;
    const int gw = vcu * NWAVES + wave, NGW = G * NWAVES;
    unsigned char* ws = a.ws;
    float* ssq = (float*)(ws + WS_SSQ);
    float* cosT = (float*)(ws + WS_COS); float* sinT = (float*)(ws + WS_SIN);
    float* lutG = (float*)(ws + WS_LUT); float* kmeanG = (float*)(ws + WS_KMEAN);
    bf16* XB = (bf16*)(ws + WS_XB);
    constexpr float LOG2E = 1.4426950408889634f;

    {
        OPAQUE_TID();
        LAS float* scr = (LAS float*)(lds + wave * 16384);
        for (int mi = 0; mi < 20; ++mi) {
            const float* W; const float* gain; bf16* WT; int K, N;
            if (mi < 8) { const int j = mi >> 2, kind = mi & 3; unsigned char* wb = ws + WS_WMLA + j * W_MLA_SZ;
                if (kind == 0) { W = a.mla_w_in + (size_t)j * 1024 * 704; gain = a.attn_norm + (2 * j) * 1024; K = 1024; N = 704; WT = (bf16*)(wb + W_MLA_IN); }
                else if (kind == 1) { W = a.mla_w_uq + (size_t)j * 384 * 1536; gain = a.mla_qa + j * 384; K = 384; N = 1536; WT = (bf16*)(wb + W_MLA_UQ); }
                else if (kind == 2) { W = a.mla_w_ukv + (size_t)j * 256 * 2048; gain = a.mla_kva + j * 256; K = 256; N = 2048; WT = (bf16*)(wb + W_MLA_UKV); }
                else { W = a.mla_w_o + (size_t)j * 1024 * 1024; gain = nullptr; K = 1024; N = 1024; WT = (bf16*)(wb + W_MLA_O); } }
            else if (mi < 12) { const int j = (mi - 8) >> 1, kind = (mi - 8) & 1; unsigned char* wb = ws + WS_WMOBA + j * W_MOBA_SZ;
                if (kind == 0) { W = a.moba_w_qkv + (size_t)j * 1024 * 3072; gain = a.attn_norm + (2 * j + 1) * 1024; K = 1024; N = 3072; WT = (bf16*)(wb + W_MOBA_QKV); }
                else { W = a.moba_w_o + (size_t)j * 1024 * 1024; gain = nullptr; K = 1024; N = 1024; WT = (bf16*)(wb + W_MOBA_O); } }
            else { const int i = (mi - 12) >> 1, kind = (mi - 12) & 1; unsigned char* wb = ws + WS_WMLP + i * W_MLP_SZ;
                if (kind == 0) { W = a.mlp_w_in + (size_t)i * 1024 * 4096; gain = a.mlp_norm + i * 1024; K = 1024; N = 4096; WT = (bf16*)(wb + W_MLP_IN); }
                else { W = a.mlp_w_out + (size_t)i * 4096 * 1024; gain = nullptr; K = 4096; N = 1024; WT = (bf16*)(wb + W_MLP_OUT); } }
            const int nitems = (K / 64) * (N / 32);
            for (int it = gw; it < nitems; it += NGW) transpose_item(W, gain, K, N, WT, scr, it, lane);
        }
        for (int i = gw * 64 + lane; i < 2 * 64 * 1024 / 8; i += NGW * 64) { const int j = i / (64 * 1024 / 8), r = i % (64 * 1024 / 8);
            *(u32x4*)(ws + WS_WMLA + j * W_MLA_SZ + W_MLA_IN + (size_t)704 * 1024 * 2 + (size_t)r * 16) = (u32x4){0u, 0u, 0u, 0u}; }
        for (int m0 = gw * 4; m0 < TOK; m0 += NGW * 4) {
            f32x4 v[4][4];
#pragma unroll
            for (int r = 0; r < 4; ++r) { const f32x4* xr = (const f32x4*)(a.x + (size_t)(m0 + r) * DM) + lane;
#pragma unroll
                for (int j = 0; j < 4; ++j) v[r][j] = __builtin_nontemporal_load(xr + 64 * j); }
#pragma unroll
            for (int r = 0; r < 4; ++r) { const int m = m0 + r; float s = 0.f;
#pragma unroll
                for (int j = 0; j < 4; ++j) s += (v[r][j].x * v[r][j].x + v[r][j].y * v[r][j].y) + (v[r][j].z * v[r][j].z + v[r][j].w * v[r][j].w);
                s = wave_sum(s); if (lane < 16) ssq[(size_t)m * 16 + lane] = (lane == 0) ? s : 0.f;
                u32x2* o8 = (u32x2*)(XB + (size_t)m * DM) + lane;
#pragma unroll
                for (int j = 0; j < 4; ++j) { u32x2 w; w.x = cvt_pk_bf16(v[r][j].x, v[r][j].y); w.y = cvt_pk_bf16(v[r][j].z, v[r][j].w); o8[64 * j] = w; } }
        }
        for (int i = bx * 512 + tid; i < TOK * 32; i += G * 512) { const int tok = i >> 5, f = i & 31;
            const float inv_freq = powf(10000.0f, -(float)(2 * f) / 64.0f);
            const float ang = (float)a.pos[tok] * inv_freq; float sv, cv; sincosf(ang, &sv, &cv); cosT[i] = cv; sinT[i] = sv; }
        for (int i = bx * 512 + tid; i < 8 * 1024; i += G * 512) { const int hh = i >> 10, n = i & 1023; int bk;
            if (n < 16) bk = n; else { const float nf = (float)n; bk = 16 + (int)(logf(nf / 16.0f) / 4.1588830833596715f * 16.0f); bk = bk > 31 ? 31 : bk; }
            lutG[i] = a.relb[bk * 8 + hh] * LOG2E; }
    }
    if (a.use_cg_sync) { grid.sync(); __builtin_amdgcn_fence(__ATOMIC_ACQUIRE, "agent"); } else GRID_SYNC();

#pragma unroll 1
    for (int layer = 0; layer < 4; ++layer) {
        const int j = layer >> 1; const bool is_mla = (layer & 1) == 0;
        float* ssq_attn = ssq + (size_t)SSQ_ATTN * TOK * 16; float* ssq_attn_next = ssq_attn; float* ssq_mlp = ssq + (size_t)SSQ_MLP * TOK * 16;
        const bf16* Oattn; const bf16* Wo_t;
        unsigned char* wbl = is_mla ? (ws + WS_WMLA + j * W_MLA_SZ) : (ws + WS_WMOBA + j * W_MOBA_SZ);
        bf16* CQ = (bf16*)(ws + WS_CQ); bf16* CKV = (bf16*)(ws + WS_CKV); bf16* KPE = (bf16*)(ws + WS_KPE);
        bf16* Q = (bf16*)(ws + WS_Q); bf16* KN = (bf16*)(ws + WS_KN); bf16* VRAW = (bf16*)(ws + WS_VRAW);
        bf16* QKV = (bf16*)(ws + WS_QKV);
        float* ssq_cq = ssq + (size_t)SSQ_CQ * TOK * 16; float* ssq_ckv = ssq + (size_t)SSQ_CKV * TOK * 16;
        if (is_mla) {
            {
                pg8::Gemm g{XB, (const bf16*)(wbl + W_MLA_IN), TOK, 768, 1024}; pg8::StaticOrder S; S.init(TOK, 768, G, bx);
                pg8::EpiGen<2> E{nullptr, 0, 0.f, CQ, 0, CKV, KPE, 0, ssq_cq, ssq_ckv, nullptr, nullptr, nullptr, nullptr, 0, (pg8::PG8_LAS_F)(lds + 131072 + 256)};
                pg8::gemm_phase<pg8::EpiGen<2>, pg8::StaticOrder, true, true>(lds, g, S, E);
            }
            GRID_SYNC();
            {
                OPAQUE_TID();
                const float* g_kr = a.mla_kr + j * 64;
                float gr[8];
#pragma unroll
                for (int e = 0; e < 8; ++e) gr[e] = g_kr[8 * (lane & 7) + e];
                for (int t0 = gw * 8; t0 < TOK; t0 += NGW * 8) {
                    const int tok = t0 + (lane >> 3), c = lane & 7;
                    bf16* ptr = KPE + (size_t)tok * 64 + c * 8;
                    const u32x4 v = *(const u32x4*)ptr;
                    const f32x4 c0 = *(const f32x4*)(cosT + tok * 32 + 8 * (c & 3)), c1 = *(const f32x4*)(cosT + tok * 32 + 8 * (c & 3) + 4);
                    const f32x4 s0 = *(const f32x4*)(sinT + tok * 32 + 8 * (c & 3)), s1 = *(const f32x4*)(sinT + tok * 32 + 8 * (c & 3) + 4);
                    float f[8]; unpack8(v, f);
                    float ss = 0.f;
#pragma unroll
                    for (int e = 0; e < 8; ++e) ss += f[e] * f[e];
                    ss += __shfl_xor(ss, 1); ss += __shfl_xor(ss, 2); ss += __shfl_xor(ss, 4);
                    const float sc = __builtin_amdgcn_rsqf(ss * (1.0f / 64.0f) + pg8::RMS_EPS_F);
                    float y[8];
#pragma unroll
                    for (int e = 0; e < 8; ++e) y[e] = f[e] * sc * gr[e];
#pragma unroll
                    for (int e = 0; e < 8; ++e) { const float pe = __shfl_xor(y[e], 4); const float cc = e < 4 ? c0[e & 3] : c1[e & 3], sn = e < 4 ? s0[e & 3] : s1[e & 3];
                        y[e] = (c & 4) ? (y[e] * cc + pe * sn) : (y[e] * cc - pe * sn); }
                    *(u32x4*)ptr = pack8(y);
                }
            }
            {
                int kq = 384; asm volatile("" : "+s"(kq));
                pg8::Gemm g{CQ, (const bf16*)(wbl + W_MLA_UQ), TOK, 1536, kq}; pg8::StaticOrder S; S.init(TOK, 1536, G, bx);
                pg8::EpiGen<0> E{nullptr, 0, 0.f, Q, 1536, nullptr, nullptr, 0, nullptr, nullptr, nullptr, nullptr, nullptr, nullptr, 0, (pg8::PG8_LAS_F)(lds + 131072 + 256)};
                pg8::gemm_phase<pg8::EpiGen<0>, pg8::StaticOrder, true, true>(lds, g, S, E);
            }
        }
        {
            pg8::Gemm g; pg8::EpiGen<4> E;
            pg8::PG8_LAS_F xl = (pg8::PG8_LAS_F)(lds + 131072 + 256);
            if (is_mla) { g = pg8::Gemm{CKV, (const bf16*)(wbl + W_MLA_UKV), TOK, 2048, 256};
                E = pg8::EpiGen<4>{ssq_ckv, 8, 1.0f / 256.0f, KN, 1024, VRAW, nullptr, 1, nullptr, nullptr, nullptr, nullptr, a.mla_kn + j * 128, nullptr, 1, xl}; }
            else { g = pg8::Gemm{XB, (const bf16*)(wbl + W_MOBA_QKV), TOK, 3072, 1024};
                E = pg8::EpiGen<4>{ssq_attn, 16, 1.0f / 1024.0f, QKV, 3072, nullptr, nullptr, 0, nullptr, nullptr, nullptr, nullptr, a.moba_kn + j * 128, kmeanG, 2, xl}; }
            pg8::StaticOrder S; S.init(g.M, g.N, G, bx);
            pg8::gemm_phase<pg8::EpiGen<4>, pg8::StaticOrder, true, true>(lds, g, S, E);
        }
        GRID_SYNC();
        if (is_mla) {
            att::Args AA{Q, 1536, KN, 1024, KPE, VRAW, 1024, (bf16*)(ws + WS_O_MLA), nullptr, nullptr, nullptr, a.mla_qn + j * 128, a.mla_qr + j * 64, cosT, sinT, 0.07216878364870322f * LOG2E, a.mla_kn + j * 128, a.mla_kr + j * 64, nullptr};
            att::attn_phase<192, false>(AA, lds, vcu, G);
            Oattn = (const bf16*)(ws + WS_O_MLA); Wo_t = (const bf16*)(wbl + W_MLA_O);
        } else {
            att::Args AA{QKV, 3072, QKV + 1024, 3072, nullptr, QKV + 2048, 3072, (bf16*)(ws + WS_O_MOBA), a.pos, lutG, kmeanG, a.moba_qn + j * 128, nullptr, nullptr, nullptr, 0.08838834764831845f * LOG2E, a.moba_kn + j * 128, nullptr, a.relb};
            att::attn_phase<128, true>(AA, lds, vcu, G);
            Oattn = (const bf16*)(ws + WS_O_MOBA); Wo_t = (const bf16*)(wbl + W_MOBA_O);
        }
        GRID_SYNC();
        unsigned char* wm = ws + WS_WMLP + layer * W_MLP_SZ;
#pragma unroll 1
        for (int rep = 0; rep < 2; ++rep) {
            {
                pg8::Gemm g; pg8::EpiGen<3> E;
                if (rep == 0) { g = pg8::Gemm{Oattn, Wo_t, TOK, 1024, 1024}; E = pg8::EpiGen<3>{nullptr, 0, 0.f, XB, 1024, nullptr, nullptr, 0, ssq_mlp, nullptr, nullptr, nullptr}; }
                else { g = pg8::Gemm{(const bf16*)(ws + WS_H), (const bf16*)(wm + W_MLP_OUT), TOK, 1024, 4096}; E = pg8::EpiGen<3>{ssq_mlp, 16, 1.0f / 1024.0f, XB, 1024, nullptr, nullptr, 0, (layer == 3) ? nullptr : ssq_attn_next, nullptr, nullptr, (layer == 3) ? a.out : nullptr, nullptr, nullptr, 0, (pg8::PG8_LAS_F)(lds + 131072 + 256)}; }
                pg8::StaticOrder S; S.init(g.M, g.N, G, bx);
                pg8::gemm_phase<pg8::EpiGen<3>, pg8::StaticOrder, true, true>(lds, g, S, E);
            }
            if (rep == 0) {
                GRID_SYNC();
                pg8::Gemm g{XB, (const bf16*)(wm + W_MLP_IN), TOK, 4096, 1024}; pg8::StaticOrder S; S.init(TOK, 4096, G, bx);
                pg8::EpiGen<1> E{nullptr, 0, 0.f, (bf16*)(ws + WS_H), 4096, nullptr, nullptr, 0, nullptr, nullptr, nullptr, nullptr, nullptr, nullptr, 0, (pg8::PG8_LAS_F)(lds + 131072 + 256)};
                pg8::gemm_phase<pg8::EpiGen<1>, pg8::StaticOrder, true, true>(lds, g, S, E);
                GRID_SYNC();
            }
        }
        if (layer < 3) GRID_SYNC();
    }
}

extern "C" void kernel_launch(void* const* d_in, const int* in_sizes, int n_in, void* d_out, int out_size, void* d_ws, size_t ws_size, hipStream_t stream) {
    static int grid = 0;
    if (grid == 0) {
        if (n_in != 21 || out_size != TOK * DM || ws_size < WS_END) { fprintf(stderr, "kernel_launch: unexpected shapes (n_in %d out %d ws %zu)\n", n_in, out_size, ws_size); grid = -1; return; }
        int dev = 0, cus = 0, per_cu = 0;
        (void)hipGetDevice(&dev);
        (void)hipDeviceGetAttribute(&cus, hipDeviceAttributeMultiprocessorCount, dev);
        (void)hipFuncSetAttribute((const void*)fwd_megakernel, hipFuncAttributeMaxDynamicSharedMemorySize, LDS_BYTES);
        (void)hipOccupancyMaxActiveBlocksPerMultiprocessor(&per_cu, (const void*)fwd_megakernel, 512, LDS_BYTES);
        if (per_cu < 1) per_cu = 1;
        grid = cus * per_cu;
        (void)hipGetLastError();
    }
    if (grid < 0) return;
    KArgs a{};
    a.x = (const float*)d_in[0]; a.pos = (const int*)d_in[1]; a.relb = (const float*)d_in[2]; a.attn_norm = (const float*)d_in[3]; a.mlp_norm = (const float*)d_in[4];
    a.mla_w_in = (const float*)d_in[5]; a.mla_qa = (const float*)d_in[6]; a.mla_kva = (const float*)d_in[7]; a.mla_w_uq = (const float*)d_in[8]; a.mla_w_ukv = (const float*)d_in[9];
    a.mla_qn = (const float*)d_in[10]; a.mla_qr = (const float*)d_in[11]; a.mla_kn = (const float*)d_in[12]; a.mla_kr = (const float*)d_in[13]; a.mla_w_o = (const float*)d_in[14];
    a.moba_w_qkv = (const float*)d_in[15]; a.moba_qn = (const float*)d_in[16]; a.moba_kn = (const float*)d_in[17]; a.moba_w_o = (const float*)d_in[18];
    a.mlp_w_in = (const float*)d_in[19]; a.mlp_w_out = (const float*)d_in[20];
    a.out = (float*)d_out; a.ws = (unsigned char*)d_ws;
    (void)hipMemsetAsync((unsigned char*)d_ws + WS_CTL, 0, CTL_BYTES, stream);
    void* args[] = {&a};
    hipError_t e = hipLaunchCooperativeKernel((const void*)fwd_megakernel, dim3(grid), dim3(512), args, LDS_BYTES, stream);
    if (e != hipSuccess) fprintf(stderr, "cooperative launch failed: %s (grid %d)\n", hipGetErrorString(e), grid);
}
```

```cpp
#include <hip/hip_runtime.h>
#include <hip/hip_cooperative_groups.h>
#include <cstdio>
#include <cstdint>
namespace cg = cooperative_groups;

namespace pg8 {
#define PG8_LAS __attribute__((address_space(3)))
typedef __attribute__((address_space(3))) float* PG8_LAS_F;
typedef unsigned short bf16_t;
typedef short bf16x8 __attribute__((ext_vector_type(8)));
typedef float f32x4 __attribute__((ext_vector_type(4)));
typedef unsigned u32x4 __attribute__((ext_vector_type(4)));
constexpr int BM = 256, BK = 64, HALF = 128, HTB = HALF * BK * 2  , STAGE_BYTES = 8 * HTB, NXCD = 8, WGM = 8;

__host__ __device__ __forceinline__ int lds_byte(int r, int c) { const int st = (r >> 4) * 2 + (c >> 5), rr = r & 15, cc = c & 31, ob = rr * 64 + cc * 2; return st * 1024 + (ob ^ (((ob >> 9) & 1) << 5)); }
__host__ __device__ __forceinline__ void stage_rc(int b, int& R, int& C) { const int st = b / 1024, sb = b % 1024, swz = sb ^ (((sb >> 9) & 1) << 5); R = (st >> 1) * 16 + swz / 64; C = (st & 1) * 32 + (swz % 64) / 2; }
__host__ __device__ __forceinline__ int perm32(int rho) { const int n = rho >> 4, i = rho & 15; return 8 * (i >> 2) + 4 * n + (i & 3); }

struct Unit { int pm, pn; };
struct Gemm { const bf16_t* A; const bf16_t* Bt; int M, N, K; };

struct StaticOrder {
    int nM, nN, nwg, G, c;
    __host__ __device__ void init(int M, int N, int G_, int c_) { nM = M / BM; nN = N / BM; nwg = nM * nN; G = G_; c = c_; }
    __host__ __device__ bool next(int i, Unit& u) const {
        const long L = (long)i * G + c; if (L >= nwg) return false;
        int wgid = (int)L; { const int q = nwg / NXCD, r = nwg % NXCD, xcd = wgid % NXCD, off = wgid / NXCD; wgid = (xcd < r ? xcd * (q + 1) : r * (q + 1) + (xcd - r) * q) + off; }
        const int nig = WGM * nN, gid = wgid / nig, fm = gid * WGM, gsz = (nM - fm) < WGM ? (nM - fm) : WGM;
        u.pm = fm + ((wgid % nig) % gsz); u.pn = (wgid % nig) / gsz; return true;
    }
    __device__ __forceinline__ void a_ready(const Unit&) const {}
    __device__ __forceinline__ void done(const Unit&) const {}
};
struct RevOrder : StaticOrder {
    __host__ __device__ bool next(int i, Unit& u) const { const int nr = nwg / G; if (i >= nr) return false; return StaticOrder::next(nr - 1 - i, u); }
};

typedef float f32x2 __attribute__((ext_vector_type(2)));
typedef __bf16 bf16x2_t __attribute__((ext_vector_type(2)));
__device__ __forceinline__ unsigned cvt_pk_bf16(float lo, float hi) { f32x2 v = {lo, hi}; bf16x2_t b = __builtin_convertvector(v, bf16x2_t); return __builtin_bit_cast(unsigned, b); }

constexpr float RMS_EPS_F = 1e-6f;
template <int MODE> struct EpiGen {
    static constexpr bool PERM = true, AFTER_DRAIN = false;
    const float* ssq_in; int nslot; float inv_k;
    bf16_t* O; int ldc; bf16_t* O2; bf16_t* O3; int split2;
    float* ssq_o1; float* ssq_o2;
    const float* base; float* out;
    const float* kgain; float* kmean; int kmode; PG8_LAS float* xl;
    __device__ __forceinline__ void epi_knorm(const f32x4 (&acc)[2][2][4][2], const Unit& u, int wr, int wc, int fr, int fq) const {
        const int hf0 = 2 * u.pn;
        const bool isk0 = (kmode == 1) ? true : (hf0 >= 8 && hf0 < 16), isk1 = (kmode == 1) ? false : isk0;
        const bool anyk = isk0 || isk1;
        PG8_LAS float* X = xl; PG8_LAS float* Y = xl + 2048;
        float sc[2][4];
#pragma unroll
        for (int ai = 0; ai < 2; ++ai)
#pragma unroll
            for (int m = 0; m < 4; ++m) {
                const int row = u.pm * BM + ai * HALF + wr * 64 + m * 16 + fr;
                sc[ai][m] = 1.f;
                if (kmode == 1 || hf0 >= 16) { const f32x4* sp = (const f32x4*)(ssq_in + (size_t)row * 16); f32x4 t = sp[0]; if (nslot > 4) t += sp[1]; if (nslot > 8) t += sp[2]; if (nslot > 12) t += sp[3];
                    sc[ai][m] = __builtin_amdgcn_rsqf(((t[0] + t[1]) + (t[2] + t[3])) * inv_k + RMS_EPS_F); }
            }
        if (anyk) {
#pragma unroll
            for (int ai = 0; ai < 2; ++ai)
#pragma unroll
                for (int m = 0; m < 4; ++m)
#pragma unroll
                    for (int bj = 0; bj < 2; ++bj) {
                        if (bj == 0 ? isk0 : isk1) {
                            const f32x4 v0 = acc[ai][bj][m][0] * sc[ai][m], v1 = acc[ai][bj][m][1] * sc[ai][m];
                            float part = (v0[0] * v0[0] + v0[1] * v0[1]) + (v0[2] * v0[2] + v0[3] * v0[3]) + (v1[0] * v1[0] + v1[1] * v1[1]) + (v1[2] * v1[2] + v1[3] * v1[3]);
                            part += __shfl_xor(part, 16); part += __shfl_xor(part, 32);
                            if (fq == 0) X[((ai * HALF + wr * 64 + m * 16 + fr) * 2 + bj) * 4 + wc] = part;
                        }
                    }
            asm volatile("s_waitcnt lgkmcnt(0)" ::: "memory"); __builtin_amdgcn_s_barrier(); asm volatile("" ::: "memory");
        }
        float cs[2][8];
#pragma unroll
        for (int bj = 0; bj < 2; ++bj)
#pragma unroll
            for (int e = 0; e < 8; ++e) cs[bj][e] = 0.f;
        const f32x4 g0 = *(const f32x4*)(kgain + wc * 32 + 8 * fq), g1 = *(const f32x4*)(kgain + wc * 32 + 8 * fq + 4);
#pragma unroll
        for (int ai = 0; ai < 2; ++ai)
#pragma unroll
            for (int m = 0; m < 4; ++m) {
                const int rowl = ai * HALF + wr * 64 + m * 16 + fr, row = u.pm * BM + rowl;
#pragma unroll
                for (int bj = 0; bj < 2; ++bj) {
                    const int hf = hf0 + bj;
                    f32x4 v0 = acc[ai][bj][m][0] * sc[ai][m], v1 = acc[ai][bj][m][1] * sc[ai][m];
                    if (bj == 0 ? isk0 : isk1) {
                        const f32x4 t = *(const PG8_LAS f32x4*)(X + (rowl * 2 + bj) * 4);
                        const float sk = __builtin_amdgcn_rsqf(((t[0] + t[1]) + (t[2] + t[3])) * (1.0f / 128.0f) + RMS_EPS_F);
                        v0 = v0 * sk * g0; v1 = v1 * sk * g1;
#pragma unroll
                        for (int e = 0; e < 4; ++e) { cs[bj][e] += v0[e]; cs[bj][4 + e] += v1[e]; }
                    }
                    bf16_t* dst;
                    if (split2) dst = ((hf & 1) ? O2 : O) + (size_t)row * ldc + (hf >> 1) * 128 + wc * 32 + 8 * fq;
                    else dst = O + (size_t)row * ldc + hf * 128 + wc * 32 + 8 * fq;
                    u32x4 w; w.x = cvt_pk_bf16(v0[0], v0[1]); w.y = cvt_pk_bf16(v0[2], v0[3]); w.z = cvt_pk_bf16(v1[0], v1[1]); w.w = cvt_pk_bf16(v1[2], v1[3]);
                    *(u32x4*)dst = w;
                }
                asm volatile("" ::: "memory");
            }
        if (kmean != nullptr && anyk) {
#pragma unroll
            for (int bj = 0; bj < 2; ++bj)
#pragma unroll
                for (int e = 0; e < 8; ++e) { float c = cs[bj][e]; c += __shfl_xor(c, 1); c += __shfl_xor(c, 2); c += __shfl_xor(c, 4); c += __shfl_xor(c, 8); cs[bj][e] = c; }
            if (fr == 0) {
#pragma unroll
                for (int bj = 0; bj < 2; ++bj)
#pragma unroll
                    for (int e = 0; e < 8; ++e) Y[(wr * 2 + bj) * 128 + wc * 32 + 8 * fq + e] = cs[bj][e];
            }
            asm volatile("s_waitcnt lgkmcnt(0)" ::: "memory"); __builtin_amdgcn_s_barrier(); asm volatile("" ::: "memory");
            const int t = (wr * 4 + wc) * 64 + fq * 16 + fr;
            if (t < 256) { const int bj = t >> 7, c = t & 127; const float sum = Y[(0 * 2 + bj) * 128 + c] + Y[(1 * 2 + bj) * 128 + c];
                const int head = hf0 + bj - 8, b = u.pm >> 3, blk = u.pm & 7;
                kmean[((size_t)(b * 8 + head) * 8 + blk) * 128 + c] = sum * (1.0f / 256.0f); }
        }
    }
    __device__ __forceinline__ void operator()(const f32x4 (&acc)[2][2][4][2], const Unit& u, int wr, int wc, int fr, int fq) const {
        if (MODE == 4) { epi_knorm(acc, u, wr, wc, fr, fq); return; }
        const int row0 = u.pm * BM + wr * 64 + fr;
        u32x4 bnn[4][2];
#define EPI_LOADH(ai_) do { if (MODE == 3) { _Pragma("unroll") for (int m_ = 0; m_ < 4; ++m_) _Pragma("unroll") for (int bj_ = 0; bj_ < 2; ++bj_) \
            bnn[m_][bj_] = *(const u32x4*)(O + (size_t)(row0 + (ai_) * HALF + m_ * 16) * ldc + u.pn * BM + bj_ * HALF + wc * 32 + 8 * fq); } } while (0)
        EPI_LOADH(0);
        const bool has_scale = nslot > 0;
        if (has_scale) {
            const int t_ = (wr * 4 + wc) * 64 + fq * 16 + fr;
            if (t_ < 256) { const f32x4* sp_ = (const f32x4*)(ssq_in + (size_t)(u.pm * BM + t_) * 16); f32x4 x_ = sp_[0]; if (nslot > 4) x_ += sp_[1]; if (nslot > 8) x_ += sp_[2]; if (nslot > 12) x_ += sp_[3];
                const float ms_ = ((x_[0] + x_[1]) + (x_[2] + x_[3])) * inv_k + RMS_EPS_F;
                xl[2560 + t_] = (MODE == 3) ? __builtin_amdgcn_rcpf(ms_) : __builtin_amdgcn_rsqf(ms_); }
            asm volatile("s_waitcnt lgkmcnt(0)" ::: "memory"); __builtin_amdgcn_s_barrier(); asm volatile("" ::: "memory");
        }
#pragma unroll
        for (int ai = 0; ai < 2; ++ai) {
            if (ai == 1) EPI_LOADH(1);
#pragma unroll
            for (int m = 0; m < 4; ++m) {
                const int row = row0 + ai * HALF + m * 16;
                float sc = 1.f; u32x4 bw0, bw1;
                if (has_scale) sc = xl[2560 + ai * HALF + wr * 64 + m * 16 + fr];
                if (MODE == 3) { bw0 = bnn[m][0]; bw1 = bnn[m][1]; }
                if (MODE == 0 || MODE == 1) {
#pragma unroll
                    for (int bj = 0; bj < 2; ++bj) {
                        const int hf = 2 * u.pn + bj;
                        bf16_t* dst;
                        if (split2) dst = ((hf & 1) ? O2 : O) + (size_t)row * ldc + (hf >> 1) * 128 + wc * 32 + 8 * fq;
                        else dst = O + (size_t)row * ldc + hf * 128 + wc * 32 + 8 * fq;
                        f32x4 v0 = acc[ai][bj][m][0] * sc, v1 = acc[ai][bj][m][1] * sc;
                        if (MODE == 1) {
#pragma unroll
                            for (int e = 0; e < 4; ++e) { float a = fmaxf(v0[e], 0.f), b = fmaxf(v1[e], 0.f); v0[e] = a * a; v1[e] = b * b; }
                        }
                        u32x4 w; w.x = cvt_pk_bf16(v0[0], v0[1]); w.y = cvt_pk_bf16(v0[2], v0[3]); w.z = cvt_pk_bf16(v1[0], v1[1]); w.w = cvt_pk_bf16(v1[2], v1[3]);
                        if (MODE == 1) asm volatile("global_store_dwordx4 %0, %1, off sc1\n\ts_nop 1" :: "v"(dst), "v"(w) : "memory");
                        else *(u32x4*)dst = w;
                    }
                } else if (MODE == 2) {
#pragma unroll
                    for (int bj = 0; bj < 2; ++bj) {
                        const int hf = 2 * u.pn + bj;
                        f32x4 v0 = acc[ai][bj][m][0] * sc, v1 = acc[ai][bj][m][1] * sc;
                        float part = (v0[0] * v0[0] + v0[1] * v0[1]) + (v0[2] * v0[2] + v0[3] * v0[3]) + (v1[0] * v1[0] + v1[1] * v1[1]) + (v1[2] * v1[2] + v1[3] * v1[3]);
                        part += __shfl_xor(part, 16); part += __shfl_xor(part, 32);
                        u32x4 w; w.x = cvt_pk_bf16(v0[0], v0[1]); w.y = cvt_pk_bf16(v0[2], v0[3]); w.z = cvt_pk_bf16(v1[0], v1[1]); w.w = cvt_pk_bf16(v1[2], v1[3]);
                        if (hf < 3) { *(u32x4*)(O + (size_t)row * 384 + hf * 128 + wc * 32 + 8 * fq) = w; if (fq == 0) ssq_o1[(size_t)row * 16 + hf * 4 + wc] = part; }
                        else if (hf < 5) { *(u32x4*)(O2 + (size_t)row * 256 + (hf - 3) * 128 + wc * 32 + 8 * fq) = w; if (fq == 0) ssq_o2[(size_t)row * 16 + (hf - 3) * 4 + wc] = part; }
                        else if (wc < 2) { *(u32x4*)(O3 + (size_t)row * 64 + wc * 32 + 8 * fq) = w; }
                    }
                } else {
                    float part = 0.f;
#pragma unroll
                    for (int bj = 0; bj < 2; ++bj) {
                        const size_t off = (size_t)row * ldc + u.pn * BM + bj * HALF + wc * 32 + 8 * fq;
                        const u32x4 b = bj == 0 ? bw0 : bw1;
                        f32x4 b0, b1;
                        b0[0] = __uint_as_float(b.x << 16); b0[1] = __uint_as_float(b.x & 0xffff0000u); b0[2] = __uint_as_float(b.y << 16); b0[3] = __uint_as_float(b.y & 0xffff0000u);
                        b1[0] = __uint_as_float(b.z << 16); b1[1] = __uint_as_float(b.z & 0xffff0000u); b1[2] = __uint_as_float(b.w << 16); b1[3] = __uint_as_float(b.w & 0xffff0000u);
                        const f32x4 v0 = b0 + acc[ai][bj][m][0] * sc, v1 = b1 + acc[ai][bj][m][1] * sc;
                        if (out != nullptr) { *(f32x4*)(out + off) = v0; *(f32x4*)(out + off + 4) = v1; }
                        part += (v0[0] * v0[0] + v0[1] * v0[1]) + (v0[2] * v0[2] + v0[3] * v0[3]) + (v1[0] * v1[0] + v1[1] * v1[1]) + (v1[2] * v1[2] + v1[3] * v1[3]);
                        if (ssq_o1 != nullptr) {
                            u32x4 w; w.x = cvt_pk_bf16(v0[0], v0[1]); w.y = cvt_pk_bf16(v0[2], v0[3]); w.z = cvt_pk_bf16(v1[0], v1[1]); w.w = cvt_pk_bf16(v1[2], v1[3]);
                            *(u32x4*)(O + off) = w;
                        }
                    }
                    part += __shfl_xor(part, 16); part += __shfl_xor(part, 32);
                    if (fq == 0 && ssq_o1 != nullptr) ssq_o1[(size_t)row * 16 + u.pn * 4 + wc] = part;
                }
                asm volatile("" ::: "memory");
            }
        }
#undef EPI_LOADH
    }
};

template <class Epi, class Sched, bool ALIGN_EPI = false, bool SP2 = false>
__device__ __forceinline__ void gemm_phase(PG8_LAS unsigned char* lds, const Gemm g, const Sched& S, const Epi& E) {
    int tid_o = threadIdx.x; asm volatile("" : "+v"(tid_o));
    const int tid = tid_o, wid = __builtin_amdgcn_readfirstlane(tid >> 6), lane = tid & 63, wr = wid >> 2, wc = wid & 3, fr = lane & 15, fq = lane >> 4;
    const int K = g.K, nt = K / BK;
    unsigned voffA[2], voffB[2];
#pragma unroll
    for (int i = 0; i < 2; ++i) { int R, C; stage_rc(tid * 16 + i * 8192, R, C); const int Rb = Epi::PERM ? ((R & ~31) + perm32(R & 31)) : R;
        voffA[i] = (unsigned)(R * K + C) * 2u; voffB[i] = (unsigned)(Rb * K + C) * 2u; }
    const size_t kstep = (size_t)(BK * 2);
    const size_t hstep = (size_t)HALF * K * 2;
    const size_t tstep = 2 * hstep;
    const unsigned ldsw = (unsigned)wid * 1024u;
    const int aoff = lds_byte(wr * 64 + fr, fq * 8), boff = lds_byte(wc * 32 + fr, fq * 8);
#define PG8_SA(b, h) (((b) * 2 + (h)) * HTB)
#define PG8_SB(b, h) ((4 + (b) * 2 + (h)) * HTB)
#define PG8_STAGE(bufoff, gbase, voff) do { _Pragma("unroll") for (int _i = 0; _i < 2; ++_i) \
        __builtin_amdgcn_global_load_lds((const unsigned*)((const char*)(gbase) + (voff)[_i]), (PG8_LAS unsigned*)(lds + (bufoff) + ldsw + _i * 8192), 16, 0, 0); } while (0)
#define PG8_LDA(dst, b, h) do { _Pragma("unroll") for (int m = 0; m < 4; ++m) _Pragma("unroll") for (int k = 0; k < 2; ++k) dst[m][k] = *(const PG8_LAS bf16x8*)(lds + PG8_SA(b, h) + aoff + m * 2048 + k * 1024); } while (0)
#define PG8_LDB(dst, b, h) do { _Pragma("unroll") for (int n = 0; n < 2; ++n) _Pragma("unroll") for (int k = 0; k < 2; ++k) dst[n][k] = *(const PG8_LAS bf16x8*)(lds + PG8_SB(b, h) + boff + n * 2048 + k * 1024); } while (0)
#define PG8_MMA(ai, bj, At, Bt) do { __builtin_amdgcn_s_setprio(1); _Pragma("unroll") for (int m = 0; m < 4; ++m) _Pragma("unroll") for (int n = 0; n < 2; ++n) _Pragma("unroll") for (int k = 0; k < 2; ++k) \
        acc[ai][bj][m][n] = __builtin_amdgcn_mfma_f32_16x16x32_bf16(Bt[n][k], At[m][k], acc[ai][bj][m][n], 0, 0, 0); __builtin_amdgcn_s_setprio(0); } while (0)
#define PG8_WAIT_V(n) asm volatile("s_waitcnt vmcnt(" #n ")" ::: "memory")
#define PG8_WAIT_L(n) asm volatile("s_waitcnt lgkmcnt(" #n ")" ::: "memory")
#define PG8_BAR __builtin_amdgcn_s_barrier()
#define PG8_SCHED __builtin_amdgcn_sched_barrier(0)
    Unit cur, nxt; int ui = 0;
    if (!S.next(0, cur)) return;
    f32x4 acc[2][2][4][2];
#pragma unroll
    for (int a = 0; a < 2; ++a)
#pragma unroll
        for (int b = 0; b < 2; ++b)
#pragma unroll
            for (int m = 0; m < 4; ++m)
#pragma unroll
                for (int n = 0; n < 2; ++n) acc[a][b][m][n] = (f32x4){0.f, 0.f, 0.f, 0.f};
    bf16x8 At[4][2], B0[2][2], B1[2][2];
    const char* cA = (const char*)g.A + (size_t)cur.pm * tstep; const char* cB = (const char*)g.Bt + (size_t)cur.pn * tstep;
    S.a_ready(cur);
    if constexpr (SP2) {
        PG8_STAGE(PG8_SB(0, 0), cB, voffB); PG8_STAGE(PG8_SB(0, 1), cB + hstep, voffB); PG8_STAGE(PG8_SA(0, 0), cA, voffA); PG8_STAGE(PG8_SA(0, 1), cA + hstep, voffA);
        if (wr == 1) PG8_BAR;
        PG8_WAIT_V(2); PG8_BAR;
        PG8_STAGE(PG8_SB(1, 0), cB + kstep, voffB); PG8_STAGE(PG8_SA(1, 0), cA + kstep, voffA); PG8_STAGE(PG8_SB(1, 1), cB + hstep + kstep, voffB);
        PG8_WAIT_V(6); PG8_BAR;
    } else {
        PG8_STAGE(PG8_SB(0, 0), cB, voffB); PG8_STAGE(PG8_SA(0, 0), cA, voffA); PG8_STAGE(PG8_SB(0, 1), cB + hstep, voffB); PG8_STAGE(PG8_SA(0, 1), cA + hstep, voffA);
        if (wr == 1) PG8_BAR;
        PG8_WAIT_V(4); PG8_BAR;
        PG8_STAGE(PG8_SB(1, 0), cB + kstep, voffB); PG8_STAGE(PG8_SA(1, 0), cA + kstep, voffA); PG8_STAGE(PG8_SB(1, 1), cB + hstep + kstep, voffB);
        PG8_WAIT_V(6); PG8_BAR;
    }
    for (;;) {
        const bool has_next = S.next(ui + 1, nxt);
        const char* nA = has_next ? (const char*)g.A + (size_t)nxt.pm * tstep : cA; const char* nB = has_next ? (const char*)g.Bt + (size_t)nxt.pn * tstep : cB;
        for (int t = 0; t < nt; t += 2) {
            const bool last = (t == nt - 2);
            const char* a1 = cA + (size_t)(t + 1) * kstep;
            const char* a2 = last ? nA : cA + (size_t)(t + 2) * kstep; const char* b2 = last ? nB : cB + (size_t)(t + 2) * kstep;
            const char* a3 = a2 + kstep; const char* b3 = b2 + kstep;
            if (last && has_next) S.a_ready(nxt);
            if constexpr (SP2) {
            PG8_LDB(B0, 0, 0); PG8_LDB(B1, 0, 1); PG8_SCHED; PG8_LDA(At, 0, 0); PG8_STAGE(PG8_SA(1, 1), a1 + hstep, voffA);
            PG8_WAIT_V(8); PG8_WAIT_L(0); PG8_BAR; PG8_MMA(0, 0, At, B0); PG8_MMA(0, 1, At, B1); PG8_BAR; PG8_SCHED;
            PG8_LDA(At, 0, 1); PG8_STAGE(PG8_SB(0, 0), b2, voffB); PG8_STAGE(PG8_SB(0, 1), b2 + hstep, voffB); PG8_STAGE(PG8_SA(0, 0), a2, voffA);
            PG8_WAIT_V(8); PG8_WAIT_L(0); PG8_BAR; PG8_MMA(1, 0, At, B0); PG8_MMA(1, 1, At, B1); PG8_BAR; PG8_SCHED;
            PG8_LDB(B0, 1, 0); PG8_LDB(B1, 1, 1); PG8_SCHED; PG8_LDA(At, 1, 0); PG8_STAGE(PG8_SA(0, 1), a2 + hstep, voffA);
            PG8_WAIT_V(8); PG8_WAIT_L(0); PG8_BAR; PG8_MMA(0, 0, At, B0); PG8_MMA(0, 1, At, B1); PG8_BAR; PG8_SCHED;
            PG8_LDA(At, 1, 1); PG8_STAGE(PG8_SB(1, 0), b3, voffB); PG8_STAGE(PG8_SB(1, 1), b3 + hstep, voffB); PG8_STAGE(PG8_SA(1, 0), a3, voffA);
            PG8_WAIT_V(8); PG8_WAIT_L(0); PG8_BAR; PG8_MMA(1, 0, At, B0); PG8_MMA(1, 1, At, B1); PG8_BAR; PG8_SCHED;
            } else {
            PG8_LDB(B0, 0, 0); PG8_SCHED; PG8_LDA(At, 0, 0); PG8_STAGE(PG8_SA(1, 1), a1 + hstep, voffA);
            PG8_WAIT_L(8); PG8_BAR; PG8_WAIT_L(0); PG8_MMA(0, 0, At, B0); PG8_BAR; PG8_SCHED;
            PG8_LDB(B1, 0, 1); PG8_STAGE(PG8_SB(0, 0), b2, voffB);
            PG8_BAR; PG8_WAIT_L(0); PG8_MMA(0, 1, At, B1); PG8_BAR;
            PG8_LDA(At, 0, 1); PG8_STAGE(PG8_SA(0, 0), a2, voffA);
            PG8_BAR; PG8_WAIT_L(0); PG8_MMA(1, 0, At, B0); PG8_BAR; PG8_SCHED;
            PG8_STAGE(PG8_SB(0, 1), b2 + hstep, voffB);
            PG8_WAIT_V(6); PG8_BAR; PG8_MMA(1, 1, At, B1); PG8_BAR;
            PG8_LDB(B0, 1, 0); PG8_SCHED; PG8_LDA(At, 1, 0); PG8_STAGE(PG8_SA(0, 1), a2 + hstep, voffA);
            PG8_WAIT_L(8); PG8_BAR; PG8_WAIT_L(0); PG8_MMA(0, 0, At, B0); PG8_BAR; PG8_SCHED;
            PG8_LDB(B1, 1, 1); PG8_STAGE(PG8_SB(1, 0), b3, voffB);
            PG8_BAR; PG8_WAIT_L(0); PG8_MMA(0, 1, At, B1); PG8_BAR;
            PG8_LDA(At, 1, 1); PG8_STAGE(PG8_SA(1, 0), a3, voffA);
            PG8_BAR; PG8_WAIT_L(0); PG8_MMA(1, 0, At, B0); PG8_BAR; PG8_SCHED;
            PG8_STAGE(PG8_SB(1, 1), b3 + hstep, voffB);
            PG8_WAIT_V(6); PG8_BAR; PG8_MMA(1, 1, At, B1); PG8_BAR;
            }
        }
        if constexpr (ALIGN_EPI) { if (wr == 0) PG8_BAR; }
        if constexpr (!Epi::AFTER_DRAIN) { E(acc, cur, wr, wc, fr, fq); S.done(cur); }
        if (!has_next) break;
#pragma unroll
        for (int a = 0; a < 2; ++a)
#pragma unroll
            for (int b = 0; b < 2; ++b)
#pragma unroll
                for (int m = 0; m < 4; ++m)
#pragma unroll
                    for (int n = 0; n < 2; ++n) acc[a][b][m][n] = (f32x4){0.f, 0.f, 0.f, 0.f};
        cur = nxt; cA = nA; cB = nB; ++ui;
        if constexpr (ALIGN_EPI) { if (wr == 1) PG8_BAR; }
    }
    PG8_WAIT_V(0);
    if constexpr (!ALIGN_EPI) { if (wr == 0) PG8_BAR; }
    PG8_BAR;
    if constexpr (Epi::AFTER_DRAIN) { E.fused(acc, cur, wr, wc, fr, fq, lds, wid, lane); S.done(cur); }
#undef PG8_SA
#undef PG8_SB
#undef PG8_STAGE
#undef PG8_LDA
#undef PG8_LDB
#undef PG8_MMA
#undef PG8_WAIT_V
#undef PG8_WAIT_L
#undef PG8_BAR
#undef PG8_SCHED
}
}

constexpr int BATCH = 16, SEQ = 2048, DM = 1024, TOK = BATCH * SEQ, NH = 8, DFF = 4096;
#define LAS __attribute__((address_space(3)))
typedef LAS unsigned char* lptr;
typedef unsigned short bf16;
typedef short bf16x8 __attribute__((ext_vector_type(8)));
typedef float f32x4 __attribute__((ext_vector_type(4)));
typedef float f32x16 __attribute__((ext_vector_type(16)));
typedef unsigned u32x4 __attribute__((ext_vector_type(4)));
typedef unsigned u32x2 __attribute__((ext_vector_type(2)));
typedef int i32x4 __attribute__((ext_vector_type(4)));
typedef short s16x4 __attribute__((ext_vector_type(4)));
using pg8::cvt_pk_bf16;
__device__ __forceinline__ float bf2f(unsigned short v) { return __uint_as_float(((unsigned)v) << 16); }
__device__ __forceinline__ float bflo(unsigned w) { return __uint_as_float(w << 16); }
__device__ __forceinline__ float bfhi(unsigned w) { return __uint_as_float(w & 0xffff0000u); }

namespace att {
constexpr int VROW = 320;
template <int DQK> struct Lay {
    static constexpr int KROW = DQK * 2 + 16, KBUF = 64 * KROW, VBUF = 64 * VROW;
    static constexpr int OFF_K = 0, OFF_V = 2 * KBUF, OFF_POS = OFF_V + 2 * VBUF, OFF_LUT = OFF_POS + 512, OFF_KM = OFF_LUT + 4096, END = OFF_KM + 4096;
};
struct Args {
    const bf16* Q; int q_pitch;
    const bf16* K1; int k1_pitch;
    const bf16* K2;
    const bf16* V; int v_pitch;
    bf16* O;
    const int* pos; const float* lut; const float* kmean;
    const float* gq_n; const float* gq_r; const float* cosT; const float* sinT; float qscale;
    const float* gk_n; const float* gk_r; const float* relb;
};
#define MFMA32(a, b, c) __builtin_amdgcn_mfma_f32_32x32x16_bf16((a), (b), (c), 0, 0, 0)

template <int DQK, bool MOBA>
__device__ __forceinline__ void attn_unit(const Args& A, int b, int h, int qb, lptr lds) {
    using L = Lay<DQK>;
    constexpr int NS = DQK / 16;
    constexpr float NEG = -1.0e30f;
    int tid_o = threadIdx.x; asm volatile("" : "+v"(tid_o));
    const int tid = tid_o, lane = tid & 63, r32 = lane & 31, hi = lane >> 5;
    const int wid = __builtin_amdgcn_readfirstlane(tid >> 6);
    const int tb = b * SEQ, q0 = qb * 256, own = qb, bh = b * NH + h;
    const int qrow = tb + q0 + wid * 32 + r32;
    const int qrel = wid * 32 + r32;
    __syncthreads();
    bf16x8 qf[NS];
    {
        const bf16* qp = A.Q + (size_t)qrow * A.q_pitch + h * DQK + 8 * hi;
#pragma unroll
        for (int s = 0; s < NS; ++s) qf[s] = *(const bf16x8*)(qp + 16 * s);
    }
    {
        float ssn = 0.f;
#pragma unroll
        for (int s = 0; s < 8; ++s)
#pragma unroll
            for (int e = 0; e < 8; ++e) { const float f = bf2f((unsigned short)qf[s][e]); ssn += f * f; }
        ssn += __shfl_xor(ssn, 32);
        const float scn = __builtin_amdgcn_rsqf(ssn * (1.0f / 128.0f) + 1e-6f) * A.qscale;
#pragma unroll
        for (int s = 0; s < 8; ++s) {
            const f32x4 g0 = *(const f32x4*)(A.gq_n + 16 * s + 8 * hi), g1 = *(const f32x4*)(A.gq_n + 16 * s + 8 * hi + 4);
            u32x4 w;
            w.x = cvt_pk_bf16(bf2f((unsigned short)qf[s][0]) * scn * g0[0], bf2f((unsigned short)qf[s][1]) * scn * g0[1]);
            w.y = cvt_pk_bf16(bf2f((unsigned short)qf[s][2]) * scn * g0[2], bf2f((unsigned short)qf[s][3]) * scn * g0[3]);
            w.z = cvt_pk_bf16(bf2f((unsigned short)qf[s][4]) * scn * g1[0], bf2f((unsigned short)qf[s][5]) * scn * g1[1]);
            w.w = cvt_pk_bf16(bf2f((unsigned short)qf[s][6]) * scn * g1[2], bf2f((unsigned short)qf[s][7]) * scn * g1[3]);
            qf[s] = __builtin_bit_cast(bf16x8, w);
        }
        if (DQK == 192) {
            float ssr = 0.f;
#pragma unroll
            for (int s = 8; s < NS; ++s)
#pragma unroll
                for (int e = 0; e < 8; ++e) { const float f = bf2f((unsigned short)qf[s][e]); ssr += f * f; }
            ssr += __shfl_xor(ssr, 32);
            const float scr = __builtin_amdgcn_rsqf(ssr * (1.0f / 64.0f) + 1e-6f);
#pragma unroll
            for (int sp = 0; sp < 2; ++sp) {
                const int i0 = 16 * sp + 8 * hi;
                float o1[8], o2[8];
                const f32x4 ga0 = *(const f32x4*)(A.gq_r + i0), ga1 = *(const f32x4*)(A.gq_r + i0 + 4), gb0 = *(const f32x4*)(A.gq_r + 32 + i0), gb1 = *(const f32x4*)(A.gq_r + 32 + i0 + 4);
                const f32x4 cc0 = *(const f32x4*)(A.cosT + (size_t)qrow * 32 + i0), cc1 = *(const f32x4*)(A.cosT + (size_t)qrow * 32 + i0 + 4);
                const f32x4 ss0 = *(const f32x4*)(A.sinT + (size_t)qrow * 32 + i0), ss1 = *(const f32x4*)(A.sinT + (size_t)qrow * 32 + i0 + 4);
#pragma unroll
                for (int e = 0; e < 8; ++e) {
                    const float x1 = bf2f((unsigned short)qf[(NS == 12 ? 8 : 0) + sp][e]) * scr * (e < 4 ? ga0[e & 3] : ga1[e & 3]);
                    const float x2 = bf2f((unsigned short)qf[(NS == 12 ? 10 : 0) + sp][e]) * scr * (e < 4 ? gb0[e & 3] : gb1[e & 3]);
                    const float c = e < 4 ? cc0[e & 3] : cc1[e & 3], sn = e < 4 ? ss0[e & 3] : ss1[e & 3];
                    o1[e] = (x1 * c - x2 * sn) * A.qscale; o2[e] = (x2 * c + x1 * sn) * A.qscale;
                }
                u32x4 w1, w2;
                w1.x = cvt_pk_bf16(o1[0], o1[1]); w1.y = cvt_pk_bf16(o1[2], o1[3]); w1.z = cvt_pk_bf16(o1[4], o1[5]); w1.w = cvt_pk_bf16(o1[6], o1[7]);
                w2.x = cvt_pk_bf16(o2[0], o2[1]); w2.y = cvt_pk_bf16(o2[2], o2[3]); w2.z = cvt_pk_bf16(o2[4], o2[5]); w2.w = cvt_pk_bf16(o2[6], o2[7]);
                qf[(NS == 12 ? 8 : 0) + sp] = __builtin_bit_cast(bf16x8, w1); qf[(NS == 12 ? 10 : 0) + sp] = __builtin_bit_cast(bf16x8, w2);
            }
        }
    }
    unsigned sel = 0xffu; int pq = 0;
    LAS float* lut = (LAS float*)(lds + L::OFF_LUT);
    if (MOBA) {
        LAS float* km = (LAS float*)(lds + L::OFF_KM);
        lut[tid] = A.lut[h * 1024 + tid]; lut[tid + 512] = A.lut[h * 1024 + tid + 512];
        km[tid] = A.kmean[(size_t)bh * 1024 + tid]; km[tid + 512] = A.kmean[(size_t)bh * 1024 + tid + 512];
        pq = A.pos[qrow];
        __syncthreads();
        if (own <= 3) sel = (1u << own) - 1u;
        else {
            float g[7];
#pragma unroll
            for (int j = 0; j < 7; ++j) {
                float a = 0.f;
                if (j < own) {
#pragma unroll
                    for (int s = 0; s < NS; ++s) {
                        const f32x4 k0 = *(const LAS f32x4*)(km + j * 128 + 16 * s + 8 * hi), k1 = *(const LAS f32x4*)(km + j * 128 + 16 * s + 8 * hi + 4);
                        a += bf2f((unsigned short)qf[s][0]) * k0[0] + bf2f((unsigned short)qf[s][1]) * k0[1] + bf2f((unsigned short)qf[s][2]) * k0[2] + bf2f((unsigned short)qf[s][3]) * k0[3];
                        a += bf2f((unsigned short)qf[s][4]) * k1[0] + bf2f((unsigned short)qf[s][5]) * k1[1] + bf2f((unsigned short)qf[s][6]) * k1[2] + bf2f((unsigned short)qf[s][7]) * k1[3];
                    }
                }
                a += __shfl_xor(a, 32);
                g[j] = a;
            }
            sel = 0u;
#pragma unroll
            for (int rnd = 0; rnd < 3; ++rnd) {
                float best = -INFINITY; int bi = -1;
#pragma unroll
                for (int j = 0; j < 7; ++j) { const bool c = (j < own) && !((sel >> j) & 1u) && (g[j] > best); best = c ? g[j] : best; bi = c ? j : bi; }
                if (bi >= 0) sel |= 1u << bi;
            }
        }
    }
    float negm;
    {
        float qss = 0.f;
#pragma unroll
        for (int s = 0; s < NS; ++s)
#pragma unroll
            for (int e = 0; e < 8; ++e) { const float f = bf2f((unsigned short)qf[s][e]); qss += f * f; }
        qss += __shfl_xor(qss, 32);
        float gmx = fmaxf(fabsf(A.gk_n[lane]), fabsf(A.gk_n[lane + 64]));
        float grx = (DQK == 192) ? fabsf(A.gk_r[lane]) : 0.f;
        float bmx = (MOBA && lane < 32) ? fabsf(A.relb[lane * 8 + h]) * 1.4426950408889634f : 0.f;
#pragma unroll
        for (int o_ = 1; o_ < 64; o_ <<= 1) { gmx = fmaxf(gmx, __shfl_xor(gmx, o_)); grx = fmaxf(grx, __shfl_xor(grx, o_)); bmx = fmaxf(bmx, __shfl_xor(bmx, o_)); }
        negm = -(sqrtf(qss * (128.0f * gmx * gmx + 64.0f * grx * grx)) * 1.01f + bmx + 0.01f);
    }
    const int NT = 4 * (own + 1);
    u32x4 kr0, kr1, kr2, vr0, vr1; int pkr = 0;
    kr2 = (u32x4){0u, 0u, 0u, 0u};
#define ATT_KEY0(t) ((((t) < 4) ? own * 4 + (t) : (t) - 4) * 64)
#define ATT_LOAD(t) do { const int key0_ = ATT_KEY0(t); \
        const bf16* kp_ = A.K1 + (size_t)(tb + key0_) * A.k1_pitch + h * 128; \
        kr0 = *(const u32x4*)(kp_ + (size_t)(tid >> 4) * A.k1_pitch + (tid & 15) * 8); \
        kr1 = *(const u32x4*)(kp_ + (size_t)((tid >> 4) + 32) * A.k1_pitch + (tid & 15) * 8); \
        if (DQK == 192) kr2 = *(const u32x4*)(A.K2 + (size_t)(tb + key0_ + (tid >> 3)) * 64 + (tid & 7) * 8); \
        const bf16* vp_ = A.V + (size_t)(tb + key0_) * A.v_pitch + h * 128; \
        vr0 = *(const u32x4*)(vp_ + (size_t)(tid >> 4) * A.v_pitch + (tid & 15) * 8); \
        vr1 = *(const u32x4*)(vp_ + (size_t)((tid >> 4) + 32) * A.v_pitch + (tid & 15) * 8); \
        if (MOBA && tid < 64) pkr = A.pos[tb + key0_ + tid]; } while (0)
#define ATT_WRITE(buf) do { lptr kb_ = lds + L::OFF_K + (buf) * L::KBUF; lptr vb_ = lds + L::OFF_V + (buf) * L::VBUF; \
        *(LAS u32x4*)(kb_ + (tid >> 4) * L::KROW + (tid & 15) * 16) = kr0; \
        *(LAS u32x4*)(kb_ + ((tid >> 4) + 32) * L::KROW + (tid & 15) * 16) = kr1; \
        if (DQK == 192) *(LAS u32x4*)(kb_ + (tid >> 3) * L::KROW + 256 + (tid & 7) * 16) = kr2; \
        *(LAS u32x4*)(vb_ + (tid >> 4) * VROW + (tid & 15) * 16) = vr0; \
        *(LAS u32x4*)(vb_ + ((tid >> 4) + 32) * VROW + (tid & 15) * 16) = vr1; \
        if (MOBA && tid < 64) ((LAS int*)(lds + L::OFF_POS + (buf) * 256))[tid] = pkr; } while (0)

    f32x16 o[4];
#pragma unroll
    for (int d = 0; d < 4; ++d)
#pragma unroll
        for (int r = 0; r < 16; ++r) o[d][r] = 0.f;
    float lrow = 0.f;

    ATT_LOAD(0); ATT_WRITE(0);
    if (NT > 1) ATT_LOAD(1);
    __syncthreads();
    for (int t = 0; t < NT; ++t) {
        const int buf = t & 1;
        if (t + 1 < NT) { ATT_WRITE(buf ^ 1); if (t + 2 < NT) ATT_LOAD(t + 2); }
        const int tt = t & 3; const bool diag = t < 4; const int blk = diag ? own : ((t - 4) >> 2);
        const bool lsel = diag || ((sel >> blk) & 1u);
        bool act;
        if (diag) act = (64 * tt < 32 * (wid + 1));
        else act = MOBA ? (__ballot(lsel) != 0ull) : true;
        if (act) {
            lptr kb = lds + L::OFF_K + buf * L::KBUF + r32 * L::KROW + 16 * hi;
            f32x16 s0, s1;
#pragma unroll
            for (int r = 0; r < 16; ++r) { s0[r] = negm; s1[r] = negm; }
            {
                bf16x8 ka[2][2], kc[2][2];
#pragma unroll
                for (int i = 0; i < 2; ++i) { ka[0][i] = *(const LAS bf16x8*)(kb + 32 * i); kc[0][i] = *(const LAS bf16x8*)(kb + 32 * L::KROW + 32 * i); }
                __builtin_amdgcn_sched_barrier(0);
#pragma unroll
                for (int sb = 0; sb < NS; sb += 2) {
                    const int cur = (sb >> 1) & 1, nxt = cur ^ 1;
                    if (sb + 2 < NS) {
#pragma unroll
                        for (int i = 0; i < 2; ++i) { ka[nxt][i] = *(const LAS bf16x8*)(kb + 32 * (sb + 2 + i)); kc[nxt][i] = *(const LAS bf16x8*)(kb + 32 * L::KROW + 32 * (sb + 2 + i)); }
                    }
                    __builtin_amdgcn_sched_barrier(0);
#pragma unroll
                    for (int i = 0; i < 2; ++i) { s0 = MFMA32(ka[cur][i], qf[sb + i], s0); s1 = MFMA32(kc[cur][i], qf[sb + i], s1); }
                    __builtin_amdgcn_sched_barrier(0);
                }
            }
            if (MOBA) {
                const LAS int* pp = (const LAS int*)(lds + L::OFF_POS + buf * 256);
#pragma unroll
                for (int a = 0; a < 4; ++a) {
                    const i32x4 p0 = *(const LAS i32x4*)(pp + 8 * a + 4 * hi), p1 = *(const LAS i32x4*)(pp + 32 + 8 * a + 4 * hi);
                    const int pa[4] = {p0.x, p0.y, p0.z, p0.w}, pb[4] = {p1.x, p1.y, p1.z, p1.w};
#pragma unroll
                    for (int e = 0; e < 4; ++e) {
                        int d0 = pq - pa[e]; d0 = d0 < 0 ? 0 : (d0 > 1023 ? 1023 : d0);
                        int d1 = pq - pb[e]; d1 = d1 < 0 ? 0 : (d1 > 1023 ? 1023 : d1);
                        s0[4 * a + e] += lut[d0]; s1[4 * a + e] += lut[d1];
                    }
                }
                if (!lsel) {
#pragma unroll
                    for (int r = 0; r < 16; ++r) { s0[r] = NEG; s1[r] = NEG; }
                }
            }
            if (diag) {
#pragma unroll
                for (int r = 0; r < 16; ++r) {
                    const int kl = 64 * tt + (r & 3) + 8 * (r >> 2) + 4 * hi;
                    if (kl > qrel) s0[r] = NEG;
                    if (kl + 32 > qrel) s1[r] = NEG;
                }
            }
            float ls = 0.f;
#pragma unroll
            for (int r = 0; r < 16; ++r) { s0[r] = __builtin_amdgcn_exp2f(s0[r]); s1[r] = __builtin_amdgcn_exp2f(s1[r]); ls += s0[r] + s1[r]; }
            lrow += ls;
            bf16x8 pb[4];
#pragma unroll
            for (int g = 0; g < 2; ++g) {
                u32x4 w0, w1;
                w0.x = cvt_pk_bf16(s0[8 * g + 0], s0[8 * g + 1]); w0.y = cvt_pk_bf16(s0[8 * g + 2], s0[8 * g + 3]); w0.z = cvt_pk_bf16(s0[8 * g + 4], s0[8 * g + 5]); w0.w = cvt_pk_bf16(s0[8 * g + 6], s0[8 * g + 7]);
                w1.x = cvt_pk_bf16(s1[8 * g + 0], s1[8 * g + 1]); w1.y = cvt_pk_bf16(s1[8 * g + 2], s1[8 * g + 3]); w1.z = cvt_pk_bf16(s1[8 * g + 4], s1[8 * g + 5]); w1.w = cvt_pk_bf16(s1[8 * g + 6], s1[8 * g + 7]);
                pb[g] = __builtin_bit_cast(bf16x8, w0); pb[2 + g] = __builtin_bit_cast(bf16x8, w1);
            }
            lptr vb = lds + L::OFF_V + buf * L::VBUF + (4 * hi + ((lane & 15) >> 2)) * VROW + ((lane >> 4) & 1) * 32 + (lane & 3) * 8;
#pragma unroll
            for (int d = 0; d < 4; ++d) {
                s16x4 lo[4], hi4[4];
#pragma unroll
                for (int g = 0; g < 4; ++g) {
                    lo[g] = __builtin_bit_cast(s16x4, __builtin_amdgcn_ds_read_tr16_b64_v4i16((LAS s16x4*)(vb + (16 * g) * VROW + d * 64)));
                    hi4[g] = __builtin_bit_cast(s16x4, __builtin_amdgcn_ds_read_tr16_b64_v4i16((LAS s16x4*)(vb + (16 * g + 8) * VROW + d * 64)));
                }
                __builtin_amdgcn_sched_barrier(0);
#pragma unroll
                for (int g = 0; g < 4; ++g) {
                    const bf16x8 av = __builtin_shufflevector(lo[g], hi4[g], 0, 1, 2, 3, 4, 5, 6, 7);
                    o[d] = MFMA32(av, pb[g], o[d]);
                }
            }
        }
        __syncthreads();
    }
    lrow += __shfl_xor(lrow, 32);
    const float inv = 1.0f / lrow;
    bf16* op = A.O + (size_t)qrow * 1024 + h * 128 + 4 * hi;
#pragma unroll
    for (int d = 0; d < 4; ++d)
#pragma unroll
        for (int a = 0; a < 4; ++a) {
            u32x2 w; w.x = cvt_pk_bf16(o[d][4 * a] * inv, o[d][4 * a + 1] * inv); w.y = cvt_pk_bf16(o[d][4 * a + 2] * inv, o[d][4 * a + 3] * inv);
            *(u32x2*)(op + 32 * d + 8 * a) = w;
        }
#undef ATT_KEY0
#undef ATT_LOAD
#undef ATT_WRITE
}

template <int DQK, bool MOBA>
__device__ __forceinline__ void attn_phase(const Args& A, lptr lds, int vcu, int G) {
    for (int v = vcu; v < 256; v += G) {
        const int x = v >> 5, c = v & 31, gq = c >> 3, k = c & 7;
#pragma unroll 1
        for (int r = 0; r < 4; ++r) {
            const int bh = x * 16 + r * 4 + gq;
            const int k2 = (k + 4) & 7;
            const int qb = (r == 0) ? k : (r == 1) ? 7 - k : (r == 2) ? k2 : 7 - k2;
            attn_unit<DQK, MOBA>(A, bh / NH, bh % NH, qb, lds);
        }
    }
}
}

constexpr size_t MiB = 1u << 20;
constexpr size_t WS_SSQ = 500 * MiB;
constexpr int SSQ_ATTN = 0, SSQ_MLP = 1, SSQ_CQ = 2, SSQ_CKV = 3, SSQ_N = 4;
constexpr size_t WS_COS = 2 * MiB, WS_SIN = 6 * MiB, WS_LUT = 10 * MiB, WS_KMEAN = 10 * MiB + 512 * 1024;
constexpr size_t WS_CTL = 11 * MiB, CTL_BYTES = 65536;
constexpr size_t WS_W = 12 * MiB;
constexpr size_t W_MLA_IN = 0, W_MLA_UQ = W_MLA_IN + (size_t)768 * 1024 * 2, W_MLA_UKV = W_MLA_UQ + (size_t)1536 * 384 * 2, W_MLA_O = W_MLA_UKV + (size_t)2048 * 256 * 2, W_MLA_SZ = W_MLA_O + (size_t)1024 * 1024 * 2;
constexpr size_t W_MOBA_QKV = 0, W_MOBA_O = (size_t)3072 * 1024 * 2, W_MOBA_SZ = W_MOBA_O + (size_t)1024 * 1024 * 2;
constexpr size_t W_MLP_IN = 0, W_MLP_OUT = (size_t)4096 * 1024 * 2, W_MLP_SZ = 2 * W_MLP_OUT;
constexpr size_t WS_WMLA = WS_W, WS_WMOBA = WS_WMLA + 2 * W_MLA_SZ, WS_WMLP = WS_WMOBA + 2 * W_MOBA_SZ, WS_WEND = WS_WMLP + 4 * W_MLP_SZ;
constexpr size_t WS_XB = 104 * MiB;
constexpr size_t WS_BIG = 168 * MiB;
constexpr size_t WS_H = WS_BIG;
constexpr size_t WS_Q = WS_BIG, WS_KN = WS_BIG + 96 * MiB, WS_VRAW = WS_BIG + 160 * MiB, WS_VT = WS_BIG + 224 * MiB, WS_O_MLA = WS_VT, WS_KPE = WS_BIG + 288 * MiB, WS_CQ = WS_BIG + 292 * MiB, WS_CKV = WS_BIG + 316 * MiB;
constexpr size_t WS_QKV = WS_BIG, WS_VT2 = WS_BIG + 192 * MiB, WS_O_MOBA = WS_BIG + 256 * MiB;
constexpr size_t WS_END = 512 * MiB;
static_assert(WS_WEND <= WS_XB && WS_CKV + 16 * MiB <= WS_SSQ && WS_O_MOBA + 64 * MiB <= WS_SSQ && WS_SSQ + 8 * MiB <= WS_END && WS_CKV + 16 * MiB <= WS_END && WS_O_MOBA + 64 * MiB <= WS_END && WS_H + 256 * MiB <= WS_END, "ws map");

constexpr int LDS_BYTES = 147456;
constexpr int NWAVES = 8;

struct KArgs {
    const float* x; const int* pos; const float* relb; const float* attn_norm; const float* mlp_norm;
    const float* mla_w_in; const float* mla_qa; const float* mla_kva; const float* mla_w_uq; const float* mla_w_ukv;
    const float* mla_qn; const float* mla_qr; const float* mla_kn; const float* mla_kr; const float* mla_w_o;
    const float* moba_w_qkv; const float* moba_qn; const float* moba_kn; const float* moba_w_o;
    const float* mlp_w_in; const float* mlp_w_out;
    float* out; unsigned char* ws;
    int use_cg_sync; int pad;
};

__device__ __forceinline__ float wave_sum(float v) {
#pragma unroll
    for (int o = 1; o < 64; o <<= 1) v += __shfl_xor(v, o);
    return v;
}

__device__ __forceinline__ void transpose_item(const float* W, const float* gain, int K, int N, bf16* WT, LAS float* scr, int item, int lane) {
    const int nblk = N / 32, kb = item / nblk, nb = item % nblk, k0 = 64 * kb, n0 = 32 * nb;
    float wv[32];
#pragma unroll
    for (int i = 0; i < 32; ++i) { const int kk = 2 * i + (lane >> 5); wv[i] = __builtin_nontemporal_load(W + (size_t)(k0 + kk) * N + n0 + (lane & 31)); }
#pragma unroll
    for (int i = 0; i < 32; ++i) { const int kk = 2 * i + (lane >> 5); const float g = gain ? gain[k0 + kk] : 1.f; scr[kk * 33 + (lane & 31)] = g * wv[i]; }
    asm volatile("s_waitcnt lgkmcnt(0)" ::: "memory");
    const int c = lane & 7;
#pragma unroll
    for (int j = 0; j < 4; ++j) { const int n = (lane >> 3) + 8 * j; const LAS float* s = scr + (8 * c) * 33 + n;
        u32x4 o; o.x = cvt_pk_bf16(s[0 * 33], s[1 * 33]); o.y = cvt_pk_bf16(s[2 * 33], s[3 * 33]); o.z = cvt_pk_bf16(s[4 * 33], s[5 * 33]); o.w = cvt_pk_bf16(s[6 * 33], s[7 * 33]);
        asm volatile("global_store_dwordx4 %0, %1, off sc1\n\ts_nop 1" :: "v"(WT + (size_t)(n0 + n) * K + k0 + 8 * c), "v"(o) : "memory"); }
    asm volatile("s_waitcnt lgkmcnt(0)" ::: "memory");
}

__device__ __forceinline__ void unpack8(const u32x4 v, float (&f)[8]) {
    f[0] = bflo(v.x); f[1] = bfhi(v.x); f[2] = bflo(v.y); f[3] = bfhi(v.y); f[4] = bflo(v.z); f[5] = bfhi(v.z); f[6] = bflo(v.w); f[7] = bfhi(v.w);
}
__device__ __forceinline__ u32x4 pack8(const float (&f)[8]) {
    u32x4 w; w.x = cvt_pk_bf16(f[0], f[1]); w.y = cvt_pk_bf16(f[2], f[3]); w.z = cvt_pk_bf16(f[4], f[5]); w.w = cvt_pk_bf16(f[6], f[7]); return w;
}

#define XB_TMO      128
#define XB_XCNT(j)  (256  + 64 * (j))
#define XB_XSUB(j)  (1280 + 64 * (j))
#define XB_XGEN(j)  (2304 + 64 * (j))
#define XB_TOP      3328
#define XB_TOPGEN   3392
#define XCD_BAR_WORDS 3456
#define XB_SPIN_CAP (1u << 18)

__device__ __forceinline__ unsigned xb_ld(unsigned* p)              { return __hip_atomic_load(p, __ATOMIC_RELAXED, __HIP_MEMORY_SCOPE_AGENT); }
__device__ __forceinline__ unsigned xb_add(unsigned* p, unsigned v) { return __hip_atomic_fetch_add(p, v, __ATOMIC_RELAXED, __HIP_MEMORY_SCOPE_AGENT); }
__device__ __forceinline__ unsigned xb_xcc_id() { return (unsigned)__builtin_amdgcn_s_getreg((3 << 11) | 20) & 0xFu; }
#define XB_SPIN(cond, bar) do { unsigned _sp = 0; while (cond) { __builtin_amdgcn_s_sleep(1); \
    if ((++_sp & 255u) == 0u) { if (xb_ld(&(bar)[XB_TMO])) break; if (_sp > XB_SPIN_CAP) { atomicAdd(&(bar)[XB_TMO], 1u); break; } } } } while (0)

struct XcdBarrier {
    unsigned* bar; unsigned x;
    volatile LAS unsigned* st;
};

__device__ __forceinline__ XcdBarrier xcd_barrier_post(unsigned* bar, volatile LAS unsigned* st) {
    XcdBarrier b; b.bar = bar; b.x = xb_xcc_id(); b.st = st;
    if (threadIdx.x == 0) (void)xb_add(&bar[XB_XCNT(b.x)], 1u);
    return b;
}
__device__ __forceinline__ void xcd_barrier_complete(unsigned* bar, unsigned x, unsigned& nloc, unsigned& nx) {
    const unsigned G = gridDim.x * gridDim.y * gridDim.z;
    unsigned sum, cnt, mine, sp = 0u;
    for (;;) {
        sum = 0u; cnt = 0u; mine = 0u;
#pragma unroll
        for (unsigned j = 0; j < 16; ++j) { const unsigned c = xb_ld(&bar[XB_XCNT(j)]); sum += c; cnt += (c > 0u) ? 1u : 0u; mine = (j == x) ? c : mine; }
        if (sum == G) break;
        __builtin_amdgcn_s_sleep(1);
        if ((++sp & 255u) == 0u) { if (xb_ld(&bar[XB_TMO])) break; if (sp > XB_SPIN_CAP) { atomicAdd(&bar[XB_TMO], 1u); break; } }
    }
    nloc = mine > 0u ? mine : 1u; nx = cnt > 0u ? cnt : 1u;
}

__device__ __forceinline__ void xcd_barrier(const XcdBarrier& b) {
    asm volatile("s_waitcnt vmcnt(0)" ::: "memory");
    __syncthreads();
    if (threadIdx.x == 0) {
        unsigned* bar = b.bar;
        __builtin_amdgcn_s_waitcnt(0);
        unsigned nloc = b.st[0], nx = b.st[1];
        if (nloc == 0u) { xcd_barrier_complete(bar, b.x, nloc, nx); b.st[0] = nloc; b.st[1] = nx; }
        const unsigned old = xb_add(&bar[XB_XSUB(b.x)], 1u);
        const unsigned gen = old / nloc;
        if (old + 1u == (gen + 1u) * nloc) {
            __builtin_amdgcn_fence(__ATOMIC_RELEASE, "agent");
            asm volatile("s_waitcnt vmcnt(0)" ::: "memory");
            const unsigned og = xb_add(&bar[XB_TOP], 1u);
            const unsigned tg = og / nx;
            if (og + 1u == (tg + 1u) * nx) xb_add(&bar[XB_TOPGEN], 1u);
            else XB_SPIN(xb_ld(&bar[XB_TOPGEN]) == tg, bar);
            __builtin_amdgcn_fence(__ATOMIC_ACQUIRE, "agent");
            xb_add(&bar[XB_XGEN(b.x)], 1u);
            asm volatile("s_waitcnt vmcnt(0)" ::: "memory");
        } else {
            XB_SPIN(xb_ld(&bar[XB_XGEN(b.x)]) == gen, bar);
            __builtin_amdgcn_fence(__ATOMIC_ACQUIRE, "agent");
            asm volatile("s_waitcnt vmcnt(0)" ::: "memory");
        }
    }
    __syncthreads();
}

__global__ void __launch_bounds__(512) fwd_megakernel(KArgs a) {
    extern __shared__ __attribute__((aligned(16))) unsigned char lds_raw[];
    cg::grid_group grid = cg::this_grid();
    lptr lds = (lptr)lds_raw;
    const int wave = __builtin_amdgcn_readfirstlane(threadIdx.x >> 6);
    const int G = gridDim.x, bx = blockIdx.x;
    volatile LAS unsigned* MISC = (volatile LAS unsigned*)(lds + 131072);
    if (threadIdx.x < 16) MISC[threadIdx.x] = 0u;
    __syncthreads();
    XcdBarrier xbar = xcd_barrier_post((unsigned*)(a.ws + WS_CTL), MISC + 8);
#define GRID_SYNC() do { xcd_barrier(xbar); } while (0)
#define OPAQUE_TID() int tid = threadIdx.x; asm volatile("" : "+v"(tid)); const int lane = tid & 63
    const int vcu = (G % 8 == 0) ? (bx % 8) * (G / 8) + bx / 8 : bx;
    const int gw = vcu * NWAVES + wave, NGW = G * NWAVES;
    unsigned char* ws = a.ws;
    float* ssq = (float*)(ws + WS_SSQ);
    float* cosT = (float*)(ws + WS_COS); float* sinT = (float*)(ws + WS_SIN);
    float* lutG = (float*)(ws + WS_LUT); float* kmeanG = (float*)(ws + WS_KMEAN);
    bf16* XB = (bf16*)(ws + WS_XB);
    constexpr float LOG2E = 1.4426950408889634f;

    {
        OPAQUE_TID();
        LAS float* scr = (LAS float*)(lds + wave * 16384);
        for (int mi = 0; mi < 20; ++mi) {
            const float* W; const float* gain; bf16* WT; int K, N;
            if (mi < 8) { const int j = mi >> 2, kind = mi & 3; unsigned char* wb = ws + WS_WMLA + j * W_MLA_SZ;
                if (kind == 0) { W = a.mla_w_in + (size_t)j * 1024 * 704; gain = a.attn_norm + (2 * j) * 1024; K = 1024; N = 704; WT = (bf16*)(wb + W_MLA_IN); }
                else if (kind == 1) { W = a.mla_w_uq + (size_t)j * 384 * 1536; gain = a.mla_qa + j * 384; K = 384; N = 1536; WT = (bf16*)(wb + W_MLA_UQ); }
                else if (kind == 2) { W = a.mla_w_ukv + (size_t)j * 256 * 2048; gain = a.mla_kva + j * 256; K = 256; N = 2048; WT = (bf16*)(wb + W_MLA_UKV); }
                else { W = a.mla_w_o + (size_t)j * 1024 * 1024; gain = nullptr; K = 1024; N = 1024; WT = (bf16*)(wb + W_MLA_O); } }
            else if (mi < 12) { const int j = (mi - 8) >> 1, kind = (mi - 8) & 1; unsigned char* wb = ws + WS_WMOBA + j * W_MOBA_SZ;
                if (kind == 0) { W = a.moba_w_qkv + (size_t)j * 1024 * 3072; gain = a.attn_norm + (2 * j + 1) * 1024; K = 1024; N = 3072; WT = (bf16*)(wb + W_MOBA_QKV); }
                else { W = a.moba_w_o + (size_t)j * 1024 * 1024; gain = nullptr; K = 1024; N = 1024; WT = (bf16*)(wb + W_MOBA_O); } }
            else { const int i = (mi - 12) >> 1, kind = (mi - 12) & 1; unsigned char* wb = ws + WS_WMLP + i * W_MLP_SZ;
                if (kind == 0) { W = a.mlp_w_in + (size_t)i * 1024 * 4096; gain = a.mlp_norm + i * 1024; K = 1024; N = 4096; WT = (bf16*)(wb + W_MLP_IN); }
                else { W = a.mlp_w_out + (size_t)i * 4096 * 1024; gain = nullptr; K = 4096; N = 1024; WT = (bf16*)(wb + W_MLP_OUT); } }
            const int nitems = (K / 64) * (N / 32);
            for (int it = gw; it < nitems; it += NGW) transpose_item(W, gain, K, N, WT, scr, it, lane);
        }
        for (int i = gw * 64 + lane; i < 2 * 64 * 1024 / 8; i += NGW * 64) { const int j = i / (64 * 1024 / 8), r = i % (64 * 1024 / 8);
            *(u32x4*)(ws + WS_WMLA + j * W_MLA_SZ + W_MLA_IN + (size_t)704 * 1024 * 2 + (size_t)r * 16) = (u32x4){0u, 0u, 0u, 0u}; }
        for (int m0 = gw * 4; m0 < TOK; m0 += NGW * 4) {
            f32x4 v[4][4];
#pragma unroll
            for (int r = 0; r < 4; ++r) { const f32x4* xr = (const f32x4*)(a.x + (size_t)(m0 + r) * DM) + lane;
#pragma unroll
                for (int j = 0; j < 4; ++j) v[r][j] = __builtin_nontemporal_load(xr + 64 * j); }
#pragma unroll
            for (int r = 0; r < 4; ++r) { const int m = m0 + r; float s = 0.f;
#pragma unroll
                for (int j = 0; j < 4; ++j) s += (v[r][j].x * v[r][j].x + v[r][j].y * v[r][j].y) + (v[r][j].z * v[r][j].z + v[r][j].w * v[r][j].w);
                s = wave_sum(s); if (lane < 16) ssq[(size_t)m * 16 + lane] = (lane == 0) ? s : 0.f;
                u32x2* o8 = (u32x2*)(XB + (size_t)m * DM) + lane;
#pragma unroll
                for (int j = 0; j < 4; ++j) { u32x2 w; w.x = cvt_pk_bf16(v[r][j].x, v[r][j].y); w.y = cvt_pk_bf16(v[r][j].z, v[r][j].w); o8[64 * j] = w; } }
        }
        for (int i = bx * 512 + tid; i < TOK * 32; i += G * 512) { const int tok = i >> 5, f = i & 31;
            const float inv_freq = powf(10000.0f, -(float)(2 * f) / 64.0f);
            const float ang = (float)a.pos[tok] * inv_freq; float sv, cv; sincosf(ang, &sv, &cv); cosT[i] = cv; sinT[i] = sv; }
        for (int i = bx * 512 + tid; i < 8 * 1024; i += G * 512) { const int hh = i >> 10, n = i & 1023; int bk;
            if (n < 16) bk = n; else { const float nf = (float)n; bk = 16 + (int)(logf(nf / 16.0f) / 4.1588830833596715f * 16.0f); bk = bk > 31 ? 31 : bk; }
            lutG[i] = a.relb[bk * 8 + hh] * LOG2E; }
    }
    if (a.use_cg_sync) { grid.sync(); __builtin_amdgcn_fence(__ATOMIC_ACQUIRE, "agent"); } else GRID_SYNC();

#pragma unroll 1
    for (int layer = 0; layer < 4; ++layer) {
        const int j = layer >> 1; const bool is_mla = (layer & 1) == 0;
        float* ssq_attn = ssq + (size_t)SSQ_ATTN * TOK * 16; float* ssq_attn_next = ssq_attn; float* ssq_mlp = ssq + (size_t)SSQ_MLP * TOK * 16;
        const bf16* Oattn; const bf16* Wo_t;
        unsigned char* wbl = is_mla ? (ws + WS_WMLA + j * W_MLA_SZ) : (ws + WS_WMOBA + j * W_MOBA_SZ);
        bf16* CQ = (bf16*)(ws + WS_CQ); bf16* CKV = (bf16*)(ws + WS_CKV); bf16* KPE = (bf16*)(ws + WS_KPE);
        bf16* Q = (bf16*)(ws + WS_Q); bf16* KN = (bf16*)(ws + WS_KN); bf16* VRAW = (bf16*)(ws + WS_VRAW);
        bf16* QKV = (bf16*)(ws + WS_QKV);
        float* ssq_cq = ssq + (size_t)SSQ_CQ * TOK * 16; float* ssq_ckv = ssq + (size_t)SSQ_CKV * TOK * 16;
        if (is_mla) {
            {
                pg8::Gemm g{XB, (const bf16*)(wbl + W_MLA_IN), TOK, 768, 1024}; pg8::StaticOrder S; S.init(TOK, 768, G, bx);
                pg8::EpiGen<2> E{nullptr, 0, 0.f, CQ, 0, CKV, KPE, 0, ssq_cq, ssq_ckv, nullptr, nullptr, nullptr, nullptr, 0, (pg8::PG8_LAS_F)(lds + 131072 + 256)};
                pg8::gemm_phase<pg8::EpiGen<2>, pg8::StaticOrder, true, true>(lds, g, S, E);
            }
            GRID_SYNC();
            {
                OPAQUE_TID();
                const float* g_kr = a.mla_kr + j * 64;
                float gr[8];
#pragma unroll
                for (int e = 0; e < 8; ++e) gr[e] = g_kr[8 * (lane & 7) + e];
                for (int t0 = gw * 8; t0 < TOK; t0 += NGW * 8) {
                    const int tok = t0 + (lane >> 3), c = lane & 7;
                    bf16* ptr = KPE + (size_t)tok * 64 + c * 8;
                    const u32x4 v = *(const u32x4*)ptr;
                    const f32x4 c0 = *(const f32x4*)(cosT + tok * 32 + 8 * (c & 3)), c1 = *(const f32x4*)(cosT + tok * 32 + 8 * (c & 3) + 4);
                    const f32x4 s0 = *(const f32x4*)(sinT + tok * 32 + 8 * (c & 3)), s1 = *(const f32x4*)(sinT + tok * 32 + 8 * (c & 3) + 4);
                    float f[8]; unpack8(v, f);
                    float ss = 0.f;
#pragma unroll
                    for (int e = 0; e < 8; ++e) ss += f[e] * f[e];
                    ss += __shfl_xor(ss, 1); ss += __shfl_xor(ss, 2); ss += __shfl_xor(ss, 4);
                    const float sc = __builtin_amdgcn_rsqf(ss * (1.0f / 64.0f) + pg8::RMS_EPS_F);
                    float y[8];
#pragma unroll
                    for (int e = 0; e < 8; ++e) y[e] = f[e] * sc * gr[e];
#pragma unroll
                    for (int e = 0; e < 8; ++e) { const float pe = __shfl_xor(y[e], 4); const float cc = e < 4 ? c0[e & 3] : c1[e & 3], sn = e < 4 ? s0[e & 3] : s1[e & 3];
                        y[e] = (c & 4) ? (y[e] * cc + pe * sn) : (y[e] * cc - pe * sn); }
                    *(u32x4*)ptr = pack8(y);
                }
            }
            {
                int kq = 384; asm volatile("" : "+s"(kq));
                pg8::Gemm g{CQ, (const bf16*)(wbl + W_MLA_UQ), TOK, 1536, kq}; pg8::StaticOrder S; S.init(TOK, 1536, G, bx);
                pg8::EpiGen<0> E{nullptr, 0, 0.f, Q, 1536, nullptr, nullptr, 0, nullptr, nullptr, nullptr, nullptr, nullptr, nullptr, 0, (pg8::PG8_LAS_F)(lds + 131072 + 256)};
                pg8::gemm_phase<pg8::EpiGen<0>, pg8::StaticOrder, true, true>(lds, g, S, E);
            }
        }
        {
            pg8::Gemm g; pg8::EpiGen<4> E;
            pg8::PG8_LAS_F xl = (pg8::PG8_LAS_F)(lds + 131072 + 256);
            if (is_mla) { g = pg8::Gemm{CKV, (const bf16*)(wbl + W_MLA_UKV), TOK, 2048, 256};
                E = pg8::EpiGen<4>{ssq_ckv, 8, 1.0f / 256.0f, KN, 1024, VRAW, nullptr, 1, nullptr, nullptr, nullptr, nullptr, a.mla_kn + j * 128, nullptr, 1, xl}; }
            else { g = pg8::Gemm{XB, (const bf16*)(wbl + W_MOBA_QKV), TOK, 3072, 1024};
                E = pg8::EpiGen<4>{ssq_attn, 16, 1.0f / 1024.0f, QKV, 3072, nullptr, nullptr, 0, nullptr, nullptr, nullptr, nullptr, a.moba_kn + j * 128, kmeanG, 2, xl}; }
            pg8::StaticOrder S; S.init(g.M, g.N, G, bx);
            pg8::gemm_phase<pg8::EpiGen<4>, pg8::StaticOrder, true, true>(lds, g, S, E);
        }
        GRID_SYNC();
        if (is_mla) {
            att::Args AA{Q, 1536, KN, 1024, KPE, VRAW, 1024, (bf16*)(ws + WS_O_MLA), nullptr, nullptr, nullptr, a.mla_qn + j * 128, a.mla_qr + j * 64, cosT, sinT, 0.07216878364870322f * LOG2E, a.mla_kn + j * 128, a.mla_kr + j * 64, nullptr};
            att::attn_phase<192, false>(AA, lds, vcu, G);
            Oattn = (const bf16*)(ws + WS_O_MLA); Wo_t = (const bf16*)(wbl + W_MLA_O);
        } else {
            att::Args AA{QKV, 3072, QKV + 1024, 3072, nullptr, QKV + 2048, 3072, (bf16*)(ws + WS_O_MOBA), a.pos, lutG, kmeanG, a.moba_qn + j * 128, nullptr, nullptr, nullptr, 0.08838834764831845f * LOG2E, a.moba_kn + j * 128, nullptr, a.relb};
            att::attn_phase<128, true>(AA, lds, vcu, G);
            Oattn = (const bf16*)(ws + WS_O_MOBA); Wo_t = (const bf16*)(wbl + W_MOBA_O);
        }
        GRID_SYNC();
        unsigned char* wm = ws + WS_WMLP + layer * W_MLP_SZ;
#pragma unroll 1
        for (int rep = 0; rep < 2; ++rep) {
            {
                pg8::Gemm g; pg8::EpiGen<3> E;
                if (rep == 0) { g = pg8::Gemm{Oattn, Wo_t, TOK, 1024, 1024}; E = pg8::EpiGen<3>{nullptr, 0, 0.f, XB, 1024, nullptr, nullptr, 0, ssq_mlp, nullptr, nullptr, nullptr}; }
                else { g = pg8::Gemm{(const bf16*)(ws + WS_H), (const bf16*)(wm + W_MLP_OUT), TOK, 1024, 4096}; E = pg8::EpiGen<3>{ssq_mlp, 16, 1.0f / 1024.0f, XB, 1024, nullptr, nullptr, 0, (layer == 3) ? nullptr : ssq_attn_next, nullptr, nullptr, (layer == 3) ? a.out : nullptr, nullptr, nullptr, 0, (pg8::PG8_LAS_F)(lds + 131072 + 256)}; }
                pg8::StaticOrder S; S.init(g.M, g.N, G, bx);
                pg8::gemm_phase<pg8::EpiGen<3>, pg8::StaticOrder, true, true>(lds, g, S, E);
            }
            if (rep == 0) {
                GRID_SYNC();
                pg8::Gemm g{XB, (const bf16*)(wm + W_MLP_IN), TOK, 4096, 1024}; pg8::RevOrder S; S.init(TOK, 4096, G, bx);
                pg8::EpiGen<1> E{nullptr, 0, 0.f, (bf16*)(ws + WS_H), 4096, nullptr, nullptr, 0, nullptr, nullptr, nullptr, nullptr, nullptr, nullptr, 0, (pg8::PG8_LAS_F)(lds + 131072 + 256)};
                pg8::gemm_phase<pg8::EpiGen<1>, pg8::RevOrder, true, true>(lds, g, S, E);
                GRID_SYNC();
            }
        }
        if (layer < 3) GRID_SYNC();
    }
}

extern "C" void kernel_launch(void* const* d_in, const int* in_sizes, int n_in, void* d_out, int out_size, void* d_ws, size_t ws_size, hipStream_t stream) {
    static int grid = 0;
    if (grid == 0) {
        if (n_in != 21 || out_size != TOK * DM || ws_size < WS_END) { fprintf(stderr, "kernel_launch: unexpected shapes (n_in %d out %d ws %zu)\n", n_in, out_size, ws_size); grid = -1; return; }
        int dev = 0, cus = 0, per_cu = 0;
        (void)hipGetDevice(&dev);
        (void)hipDeviceGetAttribute(&cus, hipDeviceAttributeMultiprocessorCount, dev);
        (void)hipFuncSetAttribute((const void*)fwd_megakernel, hipFuncAttributeMaxDynamicSharedMemorySize, LDS_BYTES);
        (void)hipOccupancyMaxActiveBlocksPerMultiprocessor(&per_cu, (const void*)fwd_megakernel, 512, LDS_BYTES);
        if (per_cu < 1) per_cu = 1;
        grid = cus * per_cu;
        (void)hipGetLastError();
    }
    if (grid < 0) return;
    KArgs a{};
    a.x = (const float*)d_in[0]; a.pos = (const int*)d_in[1]; a.relb = (const float*)d_in[2]; a.attn_norm = (const float*)d_in[3]; a.mlp_norm = (const float*)d_in[4];
    a.mla_w_in = (const float*)d_in[5]; a.mla_qa = (const float*)d_in[6]; a.mla_kva = (const float*)d_in[7]; a.mla_w_uq = (const float*)d_in[8]; a.mla_w_ukv = (const float*)d_in[9];
    a.mla_qn = (const float*)d_in[10]; a.mla_qr = (const float*)d_in[11]; a.mla_kn = (const float*)d_in[12]; a.mla_kr = (const float*)d_in[13]; a.mla_w_o = (const float*)d_in[14];
    a.moba_w_qkv = (const float*)d_in[15]; a.moba_qn = (const float*)d_in[16]; a.moba_kn = (const float*)d_in[17]; a.moba_w_o = (const float*)d_in[18];
    a.mlp_w_in = (const float*)d_in[19]; a.mlp_w_out = (const float*)d_in[20];
    a.out = (float*)d_out; a.ws = (unsigned char*)d_ws;
    (void)hipMemsetAsync((unsigned char*)d_ws + WS_CTL, 0, CTL_BYTES, stream);
    void* args[] = {&a};
    hipError_t e = hipLaunchCooperativeKernel((const void*)fwd_megakernel, dim3(grid), dim3(512), args, LDS_BYTES, stream);
    if (e != hipSuccess) fprintf(stderr, "cooperative launch failed: %s (grid %d)\n", hipGetErrorString(e), grid);
}
```

```cpp
#include <hip/hip_runtime.h>
#include <hip/hip_cooperative_groups.h>
#include <cstdio>
#include <cstdint>
namespace cg = cooperative_groups;

namespace pg8 {
#define PG8_LAS __attribute__((address_space(3)))
typedef __attribute__((address_space(3))) float* PG8_LAS_F;
typedef unsigned short bf16_t;
typedef short bf16x8 __attribute__((ext_vector_type(8)));
typedef float f32x4 __attribute__((ext_vector_type(4)));
typedef unsigned u32x4 __attribute__((ext_vector_type(4)));
constexpr int BM = 256, BK = 64, HALF = 128, HTB = HALF * BK * 2  , STAGE_BYTES = 8 * HTB, NXCD = 8, WGM = 8;

__host__ __device__ __forceinline__ int lds_byte(int r, int c) { const int st = (r >> 4) * 2 + (c >> 5), rr = r & 15, cc = c & 31, ob = rr * 64 + cc * 2; return st * 1024 + (ob ^ (((ob >> 9) & 1) << 5)); }
__host__ __device__ __forceinline__ void stage_rc(int b, int& R, int& C) { const int st = b / 1024, sb = b % 1024, swz = sb ^ (((sb >> 9) & 1) << 5); R = (st >> 1) * 16 + swz / 64; C = (st & 1) * 32 + (swz % 64) / 2; }
__host__ __device__ __forceinline__ int perm32(int rho) { const int n = rho >> 4, i = rho & 15; return 8 * (i >> 2) + 4 * n + (i & 3); }

struct Unit { int pm, pn; };
struct Gemm { const bf16_t* A; const bf16_t* Bt; int M, N, K; };

struct StaticOrder {
    int nM, nN, nwg, G, c;
    __host__ __device__ void init(int M, int N, int G_, int c_) { nM = M / BM; nN = N / BM; nwg = nM * nN; G = G_; c = c_; }
    __host__ __device__ bool next(int i, Unit& u) const {
        const long L = (long)i * G + c; if (L >= nwg) return false;
        int wgid = (int)L; { const int q = nwg / NXCD, r = nwg % NXCD, xcd = wgid % NXCD, off = wgid / NXCD; wgid = (xcd < r ? xcd * (q + 1) : r * (q + 1) + (xcd - r) * q) + off; }
        const int nig = WGM * nN, gid = wgid / nig, fm = gid * WGM, gsz = (nM - fm) < WGM ? (nM - fm) : WGM;
        u.pm = fm + ((wgid % nig) % gsz); u.pn = (wgid % nig) / gsz; return true;
    }
    __device__ __forceinline__ void a_ready(const Unit&) const {}
    __device__ __forceinline__ void done(const Unit&) const {}
};

typedef float f32x2 __attribute__((ext_vector_type(2)));
typedef __bf16 bf16x2_t __attribute__((ext_vector_type(2)));
__device__ __forceinline__ unsigned cvt_pk_bf16(float lo, float hi) { f32x2 v = {lo, hi}; bf16x2_t b = __builtin_convertvector(v, bf16x2_t); return __builtin_bit_cast(unsigned, b); }

constexpr float RMS_EPS_F = 1e-6f;
template <int MODE> struct EpiGen {
    static constexpr bool PERM = true, AFTER_DRAIN = false;
    const float* ssq_in; int nslot; float inv_k;
    bf16_t* O; int ldc; bf16_t* O2; bf16_t* O3; int split2;
    float* ssq_o1; float* ssq_o2;
    const float* base; float* out;
    const float* kgain; float* kmean; int kmode; PG8_LAS float* xl;
    __device__ __forceinline__ void epi_knorm(const f32x4 (&acc)[2][2][4][2], const Unit& u, int wr, int wc, int fr, int fq) const {
        const int hf0 = 2 * u.pn;
        const bool isk0 = (kmode == 1) ? true : (hf0 >= 8 && hf0 < 16), isk1 = (kmode == 1) ? false : isk0;
        const bool anyk = isk0 || isk1;
        PG8_LAS float* X = xl; PG8_LAS float* Y = xl + 2048;
        float sc[2][4];
#pragma unroll
        for (int ai = 0; ai < 2; ++ai)
#pragma unroll
            for (int m = 0; m < 4; ++m) {
                const int row = u.pm * BM + ai * HALF + wr * 64 + m * 16 + fr;
                sc[ai][m] = 1.f;
                if (kmode == 1 || hf0 >= 16) { const f32x4* sp = (const f32x4*)(ssq_in + (size_t)row * 16); f32x4 t = sp[0]; if (nslot > 4) t += sp[1]; if (nslot > 8) t += sp[2]; if (nslot > 12) t += sp[3];
                    sc[ai][m] = __builtin_amdgcn_rsqf(((t[0] + t[1]) + (t[2] + t[3])) * inv_k + RMS_EPS_F); }
            }
        if (anyk) {
#pragma unroll
            for (int ai = 0; ai < 2; ++ai)
#pragma unroll
                for (int m = 0; m < 4; ++m)
#pragma unroll
                    for (int bj = 0; bj < 2; ++bj) {
                        if (bj == 0 ? isk0 : isk1) {
                            const f32x4 v0 = acc[ai][bj][m][0] * sc[ai][m], v1 = acc[ai][bj][m][1] * sc[ai][m];
                            float part = (v0[0] * v0[0] + v0[1] * v0[1]) + (v0[2] * v0[2] + v0[3] * v0[3]) + (v1[0] * v1[0] + v1[1] * v1[1]) + (v1[2] * v1[2] + v1[3] * v1[3]);
                            part += __shfl_xor(part, 16); part += __shfl_xor(part, 32);
                            if (fq == 0) X[((ai * HALF + wr * 64 + m * 16 + fr) * 2 + bj) * 4 + wc] = part;
                        }
                    }
            asm volatile("s_waitcnt lgkmcnt(0)" ::: "memory"); __builtin_amdgcn_s_barrier(); asm volatile("" ::: "memory");
        }
        float cs[2][8];
#pragma unroll
        for (int bj = 0; bj < 2; ++bj)
#pragma unroll
            for (int e = 0; e < 8; ++e) cs[bj][e] = 0.f;
        const f32x4 g0 = *(const f32x4*)(kgain + wc * 32 + 8 * fq), g1 = *(const f32x4*)(kgain + wc * 32 + 8 * fq + 4);
#pragma unroll
        for (int ai = 0; ai < 2; ++ai)
#pragma unroll
            for (int m = 0; m < 4; ++m) {
                const int rowl = ai * HALF + wr * 64 + m * 16 + fr, row = u.pm * BM + rowl;
#pragma unroll
                for (int bj = 0; bj < 2; ++bj) {
                    const int hf = hf0 + bj;
                    f32x4 v0 = acc[ai][bj][m][0] * sc[ai][m], v1 = acc[ai][bj][m][1] * sc[ai][m];
                    if (bj == 0 ? isk0 : isk1) {
                        const f32x4 t = *(const PG8_LAS f32x4*)(X + (rowl * 2 + bj) * 4);
                        const float sk = __builtin_amdgcn_rsqf(((t[0] + t[1]) + (t[2] + t[3])) * (1.0f / 128.0f) + RMS_EPS_F);
                        v0 = v0 * sk * g0; v1 = v1 * sk * g1;
#pragma unroll
                        for (int e = 0; e < 4; ++e) { cs[bj][e] += v0[e]; cs[bj][4 + e] += v1[e]; }
                    }
                    bf16_t* dst;
                    if (split2) dst = ((hf & 1) ? O2 : O) + (size_t)row * ldc + (hf >> 1) * 128 + wc * 32 + 8 * fq;
                    else dst = O + (size_t)row * ldc + hf * 128 + wc * 32 + 8 * fq;
                    u32x4 w; w.x = cvt_pk_bf16(v0[0], v0[1]); w.y = cvt_pk_bf16(v0[2], v0[3]); w.z = cvt_pk_bf16(v1[0], v1[1]); w.w = cvt_pk_bf16(v1[2], v1[3]);
                    *(u32x4*)dst = w;
                }
                asm volatile("" ::: "memory");
            }
        if (kmean != nullptr && anyk) {
#pragma unroll
            for (int bj = 0; bj < 2; ++bj)
#pragma unroll
                for (int e = 0; e < 8; ++e) { float c = cs[bj][e]; c += __shfl_xor(c, 1); c += __shfl_xor(c, 2); c += __shfl_xor(c, 4); c += __shfl_xor(c, 8); cs[bj][e] = c; }
            if (fr == 0) {
#pragma unroll
                for (int bj = 0; bj < 2; ++bj)
#pragma unroll
                    for (int e = 0; e < 8; ++e) Y[(wr * 2 + bj) * 128 + wc * 32 + 8 * fq + e] = cs[bj][e];
            }
            asm volatile("s_waitcnt lgkmcnt(0)" ::: "memory"); __builtin_amdgcn_s_barrier(); asm volatile("" ::: "memory");
            const int t = (wr * 4 + wc) * 64 + fq * 16 + fr;
            if (t < 256) { const int bj = t >> 7, c = t & 127; const float sum = Y[(0 * 2 + bj) * 128 + c] + Y[(1 * 2 + bj) * 128 + c];
                const int head = hf0 + bj - 8, b = u.pm >> 3, blk = u.pm & 7;
                kmean[((size_t)(b * 8 + head) * 8 + blk) * 128 + c] = sum * (1.0f / 256.0f); }
        }
    }
    __device__ __forceinline__ void operator()(const f32x4 (&acc)[2][2][4][2], const Unit& u, int wr, int wc, int fr, int fq) const {
        if (MODE == 4) { epi_knorm(acc, u, wr, wc, fr, fq); return; }
        const int row0 = u.pm * BM + wr * 64 + fr;
        u32x4 bnn[4][2];
#define EPI_LOADH(ai_) do { if (MODE == 3) { _Pragma("unroll") for (int m_ = 0; m_ < 4; ++m_) _Pragma("unroll") for (int bj_ = 0; bj_ < 2; ++bj_) \
            bnn[m_][bj_] = *(const u32x4*)(O + (size_t)(row0 + (ai_) * HALF + m_ * 16) * ldc + u.pn * BM + bj_ * HALF + wc * 32 + 8 * fq); } } while (0)
        EPI_LOADH(0);
        const bool has_scale = nslot > 0;
        if (has_scale) {
            const int t_ = (wr * 4 + wc) * 64 + fq * 16 + fr;
            if (t_ < 256) { const f32x4* sp_ = (const f32x4*)(ssq_in + (size_t)(u.pm * BM + t_) * 16); f32x4 x_ = sp_[0]; if (nslot > 4) x_ += sp_[1]; if (nslot > 8) x_ += sp_[2]; if (nslot > 12) x_ += sp_[3];
                const float ms_ = ((x_[0] + x_[1]) + (x_[2] + x_[3])) * inv_k + RMS_EPS_F;
                xl[2560 + t_] = (MODE == 3) ? __builtin_amdgcn_rcpf(ms_) : __builtin_amdgcn_rsqf(ms_); }
            asm volatile("s_waitcnt lgkmcnt(0)" ::: "memory"); __builtin_amdgcn_s_barrier(); asm volatile("" ::: "memory");
        }
#pragma unroll
        for (int ai = 0; ai < 2; ++ai) {
            if (ai == 1) EPI_LOADH(1);
#pragma unroll
            for (int m = 0; m < 4; ++m) {
                const int row = row0 + ai * HALF + m * 16;
                float sc = 1.f; u32x4 bw0, bw1;
                if (has_scale) sc = xl[2560 + ai * HALF + wr * 64 + m * 16 + fr];
                if (MODE == 3) { bw0 = bnn[m][0]; bw1 = bnn[m][1]; }
                if (MODE == 0 || MODE == 1) {
#pragma unroll
                    for (int bj = 0; bj < 2; ++bj) {
                        const int hf = 2 * u.pn + bj;
                        bf16_t* dst;
                        if (split2) dst = ((hf & 1) ? O2 : O) + (size_t)row * ldc + (hf >> 1) * 128 + wc * 32 + 8 * fq;
                        else dst = O + (size_t)row * ldc + hf * 128 + wc * 32 + 8 * fq;
                        f32x4 v0 = acc[ai][bj][m][0] * sc, v1 = acc[ai][bj][m][1] * sc;
                        if (MODE == 1) {
#pragma unroll
                            for (int e = 0; e < 4; ++e) { float a = fmaxf(v0[e], 0.f), b = fmaxf(v1[e], 0.f); v0[e] = a * a; v1[e] = b * b; }
                        }
                        u32x4 w; w.x = cvt_pk_bf16(v0[0], v0[1]); w.y = cvt_pk_bf16(v0[2], v0[3]); w.z = cvt_pk_bf16(v1[0], v1[1]); w.w = cvt_pk_bf16(v1[2], v1[3]);
                        if (MODE == 1) asm volatile("global_store_dwordx4 %0, %1, off sc1\n\ts_nop 1" :: "v"(dst), "v"(w) : "memory");
                        else *(u32x4*)dst = w;
                    }
                } else if (MODE == 2) {
#pragma unroll
                    for (int bj = 0; bj < 2; ++bj) {
                        const int hf = 2 * u.pn + bj;
                        f32x4 v0 = acc[ai][bj][m][0] * sc, v1 = acc[ai][bj][m][1] * sc;
                        float part = (v0[0] * v0[0] + v0[1] * v0[1]) + (v0[2] * v0[2] + v0[3] * v0[3]) + (v1[0] * v1[0] + v1[1] * v1[1]) + (v1[2] * v1[2] + v1[3] * v1[3]);
                        part += __shfl_xor(part, 16); part += __shfl_xor(part, 32);
                        u32x4 w; w.x = cvt_pk_bf16(v0[0], v0[1]); w.y = cvt_pk_bf16(v0[2], v0[3]); w.z = cvt_pk_bf16(v1[0], v1[1]); w.w = cvt_pk_bf16(v1[2], v1[3]);
                        if (hf < 3) { *(u32x4*)(O + (size_t)row * 384 + hf * 128 + wc * 32 + 8 * fq) = w; if (fq == 0) ssq_o1[(size_t)row * 16 + hf * 4 + wc] = part; }
                        else if (hf < 5) { *(u32x4*)(O2 + (size_t)row * 256 + (hf - 3) * 128 + wc * 32 + 8 * fq) = w; if (fq == 0) ssq_o2[(size_t)row * 16 + (hf - 3) * 4 + wc] = part; }
                        else if (wc < 2) { *(u32x4*)(O3 + (size_t)row * 64 + wc * 32 + 8 * fq) = w; }
                    }
                } else {
                    float part = 0.f;
#pragma unroll
                    for (int bj = 0; bj < 2; ++bj) {
                        const size_t off = (size_t)row * ldc + u.pn * BM + bj * HALF + wc * 32 + 8 * fq;
                        const u32x4 b = bj == 0 ? bw0 : bw1;
                        f32x4 b0, b1;
                        b0[0] = __uint_as_float(b.x << 16); b0[1] = __uint_as_float(b.x & 0xffff0000u); b0[2] = __uint_as_float(b.y << 16); b0[3] = __uint_as_float(b.y & 0xffff0000u);
                        b1[0] = __uint_as_float(b.z << 16); b1[1] = __uint_as_float(b.z & 0xffff0000u); b1[2] = __uint_as_float(b.w << 16); b1[3] = __uint_as_float(b.w & 0xffff0000u);
                        const f32x4 v0 = b0 + acc[ai][bj][m][0] * sc, v1 = b1 + acc[ai][bj][m][1] * sc;
                        if (out != nullptr) { *(f32x4*)(out + off) = v0; *(f32x4*)(out + off + 4) = v1; }
                        part += (v0[0] * v0[0] + v0[1] * v0[1]) + (v0[2] * v0[2] + v0[3] * v0[3]) + (v1[0] * v1[0] + v1[1] * v1[1]) + (v1[2] * v1[2] + v1[3] * v1[3]);
                        if (ssq_o1 != nullptr) {
                            u32x4 w; w.x = cvt_pk_bf16(v0[0], v0[1]); w.y = cvt_pk_bf16(v0[2], v0[3]); w.z = cvt_pk_bf16(v1[0], v1[1]); w.w = cvt_pk_bf16(v1[2], v1[3]);
                            *(u32x4*)(O + off) = w;
                        }
                    }
                    part += __shfl_xor(part, 16); part += __shfl_xor(part, 32);
                    if (fq == 0 && ssq_o1 != nullptr) ssq_o1[(size_t)row * 16 + u.pn * 4 + wc] = part;
                }
                asm volatile("" ::: "memory");
            }
        }
#undef EPI_LOADH
    }
};

template <class Epi, class Sched, bool ALIGN_EPI = false, bool SP2 = false>
__device__ __forceinline__ void gemm_phase(PG8_LAS unsigned char* lds, const Gemm g, const Sched& S, const Epi& E) {
    int tid_o = threadIdx.x; asm volatile("" : "+v"(tid_o));
    const int tid = tid_o, wid = __builtin_amdgcn_readfirstlane(tid >> 6), lane = tid & 63, wr = wid >> 2, wc = wid & 3, fr = lane & 15, fq = lane >> 4;
    const int K = g.K, nt = K / BK;
    unsigned voffA[2], voffB[2];
#pragma unroll
    for (int i = 0; i < 2; ++i) { int R, C; stage_rc(tid * 16 + i * 8192, R, C); const int Rb = Epi::PERM ? ((R & ~31) + perm32(R & 31)) : R;
        voffA[i] = (unsigned)(R * K + C) * 2u; voffB[i] = (unsigned)(Rb * K + C) * 2u; }
    const size_t kstep = (size_t)(BK * 2);
    const size_t hstep = (size_t)HALF * K * 2;
    const size_t tstep = 2 * hstep;
    const unsigned ldsw = (unsigned)wid * 1024u;
    const int aoff = lds_byte(wr * 64 + fr, fq * 8), boff = lds_byte(wc * 32 + fr, fq * 8);
#define PG8_SA(b, h) (((b) * 2 + (h)) * HTB)
#define PG8_SB(b, h) ((4 + (b) * 2 + (h)) * HTB)
#define PG8_STAGE(bufoff, gbase, voff) do { _Pragma("unroll") for (int _i = 0; _i < 2; ++_i) \
        __builtin_amdgcn_global_load_lds((const unsigned*)((const char*)(gbase) + (voff)[_i]), (PG8_LAS unsigned*)(lds + (bufoff) + ldsw + _i * 8192), 16, 0, 0); } while (0)
#define PG8_LDA(dst, b, h) do { _Pragma("unroll") for (int m = 0; m < 4; ++m) _Pragma("unroll") for (int k = 0; k < 2; ++k) dst[m][k] = *(const PG8_LAS bf16x8*)(lds + PG8_SA(b, h) + aoff + m * 2048 + k * 1024); } while (0)
#define PG8_LDB(dst, b, h) do { _Pragma("unroll") for (int n = 0; n < 2; ++n) _Pragma("unroll") for (int k = 0; k < 2; ++k) dst[n][k] = *(const PG8_LAS bf16x8*)(lds + PG8_SB(b, h) + boff + n * 2048 + k * 1024); } while (0)
#define PG8_MMA(ai, bj, At, Bt) do { __builtin_amdgcn_s_setprio(1); _Pragma("unroll") for (int m = 0; m < 4; ++m) _Pragma("unroll") for (int n = 0; n < 2; ++n) _Pragma("unroll") for (int k = 0; k < 2; ++k) \
        acc[ai][bj][m][n] = __builtin_amdgcn_mfma_f32_16x16x32_bf16(Bt[n][k], At[m][k], acc[ai][bj][m][n], 0, 0, 0); __builtin_amdgcn_s_setprio(0); } while (0)
#define PG8_WAIT_V(n) asm volatile("s_waitcnt vmcnt(" #n ")" ::: "memory")
#define PG8_WAIT_L(n) asm volatile("s_waitcnt lgkmcnt(" #n ")" ::: "memory")
#define PG8_BAR __builtin_amdgcn_s_barrier()
#define PG8_SCHED __builtin_amdgcn_sched_barrier(0)
    Unit cur, nxt; int ui = 0;
    if (!S.next(0, cur)) return;
    f32x4 acc[2][2][4][2];
#pragma unroll
    for (int a = 0; a < 2; ++a)
#pragma unroll
        for (int b = 0; b < 2; ++b)
#pragma unroll
            for (int m = 0; m < 4; ++m)
#pragma unroll
                for (int n = 0; n < 2; ++n) acc[a][b][m][n] = (f32x4){0.f, 0.f, 0.f, 0.f};
    bf16x8 At[4][2], B0[2][2], B1[2][2];
    const char* cA = (const char*)g.A + (size_t)cur.pm * tstep; const char* cB = (const char*)g.Bt + (size_t)cur.pn * tstep;
    S.a_ready(cur);
    if constexpr (SP2) {
        PG8_STAGE(PG8_SB(0, 0), cB, voffB); PG8_STAGE(PG8_SB(0, 1), cB + hstep, voffB); PG8_STAGE(PG8_SA(0, 0), cA, voffA); PG8_STAGE(PG8_SA(0, 1), cA + hstep, voffA);
        if (wr == 1) PG8_BAR;
        PG8_WAIT_V(2); PG8_BAR;
        PG8_STAGE(PG8_SB(1, 0), cB + kstep, voffB); PG8_STAGE(PG8_SA(1, 0), cA + kstep, voffA); PG8_STAGE(PG8_SB(1, 1), cB + hstep + kstep, voffB);
        PG8_WAIT_V(6); PG8_BAR;
    } else {
        PG8_STAGE(PG8_SB(0, 0), cB, voffB); PG8_STAGE(PG8_SA(0, 0), cA, voffA); PG8_STAGE(PG8_SB(0, 1), cB + hstep, voffB); PG8_STAGE(PG8_SA(0, 1), cA + hstep, voffA);
        if (wr == 1) PG8_BAR;
        PG8_WAIT_V(4); PG8_BAR;
        PG8_STAGE(PG8_SB(1, 0), cB + kstep, voffB); PG8_STAGE(PG8_SA(1, 0), cA + kstep, voffA); PG8_STAGE(PG8_SB(1, 1), cB + hstep + kstep, voffB);
        PG8_WAIT_V(6); PG8_BAR;
    }
    for (;;) {
        const bool has_next = S.next(ui + 1, nxt);
        const char* nA = has_next ? (const char*)g.A + (size_t)nxt.pm * tstep : cA; const char* nB = has_next ? (const char*)g.Bt + (size_t)nxt.pn * tstep : cB;
        for (int t = 0; t < nt; t += 2) {
            const bool last = (t == nt - 2);
            const char* a1 = cA + (size_t)(t + 1) * kstep;
            const char* a2 = last ? nA : cA + (size_t)(t + 2) * kstep; const char* b2 = last ? nB : cB + (size_t)(t + 2) * kstep;
            const char* a3 = a2 + kstep; const char* b3 = b2 + kstep;
            if (last && has_next) S.a_ready(nxt);
            if constexpr (SP2) {
            PG8_LDB(B0, 0, 0); PG8_LDB(B1, 0, 1); PG8_SCHED; PG8_LDA(At, 0, 0); PG8_STAGE(PG8_SA(1, 1), a1 + hstep, voffA);
            PG8_WAIT_V(8); PG8_WAIT_L(0); PG8_BAR; PG8_MMA(0, 0, At, B0); PG8_MMA(0, 1, At, B1); PG8_BAR; PG8_SCHED;
            PG8_LDA(At, 0, 1); PG8_STAGE(PG8_SB(0, 0), b2, voffB); PG8_STAGE(PG8_SB(0, 1), b2 + hstep, voffB); PG8_STAGE(PG8_SA(0, 0), a2, voffA);
            PG8_WAIT_V(8); PG8_WAIT_L(0); PG8_BAR; PG8_MMA(1, 0, At, B0); PG8_MMA(1, 1, At, B1); PG8_BAR; PG8_SCHED;
            PG8_LDB(B0, 1, 0); PG8_LDB(B1, 1, 1); PG8_SCHED; PG8_LDA(At, 1, 0); PG8_STAGE(PG8_SA(0, 1), a2 + hstep, voffA);
            PG8_WAIT_V(8); PG8_WAIT_L(0); PG8_BAR; PG8_MMA(0, 0, At, B0); PG8_MMA(0, 1, At, B1); PG8_BAR; PG8_SCHED;
            PG8_LDA(At, 1, 1); PG8_STAGE(PG8_SB(1, 0), b3, voffB); PG8_STAGE(PG8_SB(1, 1), b3 + hstep, voffB); PG8_STAGE(PG8_SA(1, 0), a3, voffA);
            PG8_WAIT_V(8); PG8_WAIT_L(0); PG8_BAR; PG8_MMA(1, 0, At, B0); PG8_MMA(1, 1, At, B1); PG8_BAR; PG8_SCHED;
            } else {
            PG8_LDB(B0, 0, 0); PG8_SCHED; PG8_LDA(At, 0, 0); PG8_STAGE(PG8_SA(1, 1), a1 + hstep, voffA);
            PG8_WAIT_L(8); PG8_BAR; PG8_WAIT_L(0); PG8_MMA(0, 0, At, B0); PG8_BAR; PG8_SCHED;
            PG8_LDB(B1, 0, 1); PG8_STAGE(PG8_SB(0, 0), b2, voffB);
            PG8_BAR; PG8_WAIT_L(0); PG8_MMA(0, 1, At, B1); PG8_BAR;
            PG8_LDA(At, 0, 1); PG8_STAGE(PG8_SA(0, 0), a2, voffA);
            PG8_BAR; PG8_WAIT_L(0); PG8_MMA(1, 0, At, B0); PG8_BAR; PG8_SCHED;
            PG8_STAGE(PG8_SB(0, 1), b2 + hstep, voffB);
            PG8_WAIT_V(6); PG8_BAR; PG8_MMA(1, 1, At, B1); PG8_BAR;
            PG8_LDB(B0, 1, 0); PG8_SCHED; PG8_LDA(At, 1, 0); PG8_STAGE(PG8_SA(0, 1), a2 + hstep, voffA);
            PG8_WAIT_L(8); PG8_BAR; PG8_WAIT_L(0); PG8_MMA(0, 0, At, B0); PG8_BAR; PG8_SCHED;
            PG8_LDB(B1, 1, 1); PG8_STAGE(PG8_SB(1, 0), b3, voffB);
            PG8_BAR; PG8_WAIT_L(0); PG8_MMA(0, 1, At, B1); PG8_BAR;
            PG8_LDA(At, 1, 1); PG8_STAGE(PG8_SA(1, 0), a3, voffA);
            PG8_BAR; PG8_WAIT_L(0); PG8_MMA(1, 0, At, B0); PG8_BAR; PG8_SCHED;
            PG8_STAGE(PG8_SB(1, 1), b3 + hstep, voffB);
            PG8_WAIT_V(6); PG8_BAR; PG8_MMA(1, 1, At, B1); PG8_BAR;
            }
        }
        if constexpr (ALIGN_EPI) { if (wr == 0) PG8_BAR; }
        if constexpr (!Epi::AFTER_DRAIN) { E(acc, cur, wr, wc, fr, fq); S.done(cur); }
        if (!has_next) break;
#pragma unroll
        for (int a = 0; a < 2; ++a)
#pragma unroll
            for (int b = 0; b < 2; ++b)
#pragma unroll
                for (int m = 0; m < 4; ++m)
#pragma unroll
                    for (int n = 0; n < 2; ++n) acc[a][b][m][n] = (f32x4){0.f, 0.f, 0.f, 0.f};
        cur = nxt; cA = nA; cB = nB; ++ui;
        if constexpr (ALIGN_EPI) { if (wr == 1) PG8_BAR; }
    }
    PG8_WAIT_V(0);
    if constexpr (!ALIGN_EPI) { if (wr == 0) PG8_BAR; }
    PG8_BAR;
    if constexpr (Epi::AFTER_DRAIN) { E.fused(acc, cur, wr, wc, fr, fq, lds, wid, lane); S.done(cur); }
#undef PG8_SA
#undef PG8_SB
#undef PG8_STAGE
#undef PG8_LDA
#undef PG8_LDB
#undef PG8_MMA
#undef PG8_WAIT_V
#undef PG8_WAIT_L
#undef PG8_BAR
#undef PG8_SCHED
}
}

constexpr int BATCH = 16, SEQ = 2048, DM = 1024, TOK = BATCH * SEQ, NH = 8, DFF = 4096;
#define LAS __attribute__((address_space(3)))
typedef LAS unsigned char* lptr;
typedef unsigned short bf16;
typedef short bf16x8 __attribute__((ext_vector_type(8)));
typedef float f32x4 __attribute__((ext_vector_type(4)));
typedef float f32x16 __attribute__((ext_vector_type(16)));
typedef unsigned u32x4 __attribute__((ext_vector_type(4)));
typedef unsigned u32x2 __attribute__((ext_vector_type(2)));
typedef int i32x4 __attribute__((ext_vector_type(4)));
typedef short s16x4 __attribute__((ext_vector_type(4)));
using pg8::cvt_pk_bf16;
__device__ __forceinline__ float bf2f(unsigned short v) { return __uint_as_float(((unsigned)v) << 16); }
__device__ __forceinline__ float bflo(unsigned w) { return __uint_as_float(w << 16); }
__device__ __forceinline__ float bfhi(unsigned w) { return __uint_as_float(w & 0xffff0000u); }

namespace att {
constexpr int VROW = 320;
template <int DQK> struct Lay {
    static constexpr int KROW = DQK * 2 + 16, KBUF = 64 * KROW, VBUF = 64 * VROW;
    static constexpr int OFF_K = 0, OFF_V = 2 * KBUF, OFF_POS = OFF_V + 2 * VBUF, OFF_LUT = OFF_POS + 512, OFF_KM = OFF_LUT + 4096, END = OFF_KM + 4096;
};
struct Args {
    const bf16* Q; int q_pitch;
    const bf16* K1; int k1_pitch;
    const bf16* K2;
    const bf16* V; int v_pitch;
    bf16* O;
    const int* pos; const float* lut; const float* kmean;
    const float* gq_n; const float* gq_r; const float* cosT; const float* sinT; float qscale;
    const float* gk_n; const float* gk_r; const float* relb;
};
#define MFMA32(a, b, c) __builtin_amdgcn_mfma_f32_32x32x16_bf16((a), (b), (c), 0, 0, 0)

template <int DQK, bool MOBA>
__device__ __forceinline__ void attn_unit(const Args& A, int b, int h, int qb, lptr lds) {
    using L = Lay<DQK>;
    constexpr int NS = DQK / 16;
    constexpr float NEG = -1.0e30f;
    int tid_o = threadIdx.x; asm volatile("" : "+v"(tid_o));
    const int tid = tid_o, lane = tid & 63, r32 = lane & 31, hi = lane >> 5;
    const int wid = __builtin_amdgcn_readfirstlane(tid >> 6);
    const int tb = b * SEQ, q0 = qb * 256, own = qb, bh = b * NH + h;
    const int qrow = tb + q0 + wid * 32 + r32;
    const int qrel = wid * 32 + r32;
    __syncthreads();
    bf16x8 qf[NS];
    {
        const bf16* qp = A.Q + (size_t)qrow * A.q_pitch + h * DQK + 8 * hi;
#pragma unroll
        for (int s = 0; s < NS; ++s) qf[s] = *(const bf16x8*)(qp + 16 * s);
    }
    {
        float ssn = 0.f;
#pragma unroll
        for (int s = 0; s < 8; ++s)
#pragma unroll
            for (int e = 0; e < 8; ++e) { const float f = bf2f((unsigned short)qf[s][e]); ssn += f * f; }
        ssn += __shfl_xor(ssn, 32);
        const float scn = __builtin_amdgcn_rsqf(ssn * (1.0f / 128.0f) + 1e-6f) * A.qscale;
#pragma unroll
        for (int s = 0; s < 8; ++s) {
            const f32x4 g0 = *(const f32x4*)(A.gq_n + 16 * s + 8 * hi), g1 = *(const f32x4*)(A.gq_n + 16 * s + 8 * hi + 4);
            u32x4 w;
            w.x = cvt_pk_bf16(bf2f((unsigned short)qf[s][0]) * scn * g0[0], bf2f((unsigned short)qf[s][1]) * scn * g0[1]);
            w.y = cvt_pk_bf16(bf2f((unsigned short)qf[s][2]) * scn * g0[2], bf2f((unsigned short)qf[s][3]) * scn * g0[3]);
            w.z = cvt_pk_bf16(bf2f((unsigned short)qf[s][4]) * scn * g1[0], bf2f((unsigned short)qf[s][5]) * scn * g1[1]);
            w.w = cvt_pk_bf16(bf2f((unsigned short)qf[s][6]) * scn * g1[2], bf2f((unsigned short)qf[s][7]) * scn * g1[3]);
            qf[s] = __builtin_bit_cast(bf16x8, w);
        }
        if (DQK == 192) {
            float ssr = 0.f;
#pragma unroll
            for (int s = 8; s < NS; ++s)
#pragma unroll
                for (int e = 0; e < 8; ++e) { const float f = bf2f((unsigned short)qf[s][e]); ssr += f * f; }
            ssr += __shfl_xor(ssr, 32);
            const float scr = __builtin_amdgcn_rsqf(ssr * (1.0f / 64.0f) + 1e-6f);
#pragma unroll
            for (int sp = 0; sp < 2; ++sp) {
                const int i0 = 16 * sp + 8 * hi;
                float o1[8], o2[8];
                const f32x4 ga0 = *(const f32x4*)(A.gq_r + i0), ga1 = *(const f32x4*)(A.gq_r + i0 + 4), gb0 = *(const f32x4*)(A.gq_r + 32 + i0), gb1 = *(const f32x4*)(A.gq_r + 32 + i0 + 4);
                const f32x4 cc0 = *(const f32x4*)(A.cosT + (size_t)qrow * 32 + i0), cc1 = *(const f32x4*)(A.cosT + (size_t)qrow * 32 + i0 + 4);
                const f32x4 ss0 = *(const f32x4*)(A.sinT + (size_t)qrow * 32 + i0), ss1 = *(const f32x4*)(A.sinT + (size_t)qrow * 32 + i0 + 4);
#pragma unroll
                for (int e = 0; e < 8; ++e) {
                    const float x1 = bf2f((unsigned short)qf[(NS == 12 ? 8 : 0) + sp][e]) * scr * (e < 4 ? ga0[e & 3] : ga1[e & 3]);
                    const float x2 = bf2f((unsigned short)qf[(NS == 12 ? 10 : 0) + sp][e]) * scr * (e < 4 ? gb0[e & 3] : gb1[e & 3]);
                    const float c = e < 4 ? cc0[e & 3] : cc1[e & 3], sn = e < 4 ? ss0[e & 3] : ss1[e & 3];
                    o1[e] = (x1 * c - x2 * sn) * A.qscale; o2[e] = (x2 * c + x1 * sn) * A.qscale;
                }
                u32x4 w1, w2;
                w1.x = cvt_pk_bf16(o1[0], o1[1]); w1.y = cvt_pk_bf16(o1[2], o1[3]); w1.z = cvt_pk_bf16(o1[4], o1[5]); w1.w = cvt_pk_bf16(o1[6], o1[7]);
                w2.x = cvt_pk_bf16(o2[0], o2[1]); w2.y = cvt_pk_bf16(o2[2], o2[3]); w2.z = cvt_pk_bf16(o2[4], o2[5]); w2.w = cvt_pk_bf16(o2[6], o2[7]);
                qf[(NS == 12 ? 8 : 0) + sp] = __builtin_bit_cast(bf16x8, w1); qf[(NS == 12 ? 10 : 0) + sp] = __builtin_bit_cast(bf16x8, w2);
            }
        }
    }
    unsigned sel = 0xffu; int pq = 0;
    LAS float* lut = (LAS float*)(lds + L::OFF_LUT);
    if (MOBA) {
        LAS float* km = (LAS float*)(lds + L::OFF_KM);
        lut[tid] = A.lut[h * 1024 + tid]; lut[tid + 512] = A.lut[h * 1024 + tid + 512];
        km[tid] = A.kmean[(size_t)bh * 1024 + tid]; km[tid + 512] = A.kmean[(size_t)bh * 1024 + tid + 512];
        pq = A.pos[qrow];
        __syncthreads();
        if (own <= 3) sel = (1u << own) - 1u;
        else {
            float g[7];
#pragma unroll
            for (int j = 0; j < 7; ++j) {
                float a = 0.f;
                if (j < own) {
#pragma unroll
                    for (int s = 0; s < NS; ++s) {
                        const f32x4 k0 = *(const LAS f32x4*)(km + j * 128 + 16 * s + 8 * hi), k1 = *(const LAS f32x4*)(km + j * 128 + 16 * s + 8 * hi + 4);
                        a += bf2f((unsigned short)qf[s][0]) * k0[0] + bf2f((unsigned short)qf[s][1]) * k0[1] + bf2f((unsigned short)qf[s][2]) * k0[2] + bf2f((unsigned short)qf[s][3]) * k0[3];
                        a += bf2f((unsigned short)qf[s][4]) * k1[0] + bf2f((unsigned short)qf[s][5]) * k1[1] + bf2f((unsigned short)qf[s][6]) * k1[2] + bf2f((unsigned short)qf[s][7]) * k1[3];
                    }
                }
                a += __shfl_xor(a, 32);
                g[j] = a;
            }
            sel = 0u;
#pragma unroll
            for (int rnd = 0; rnd < 3; ++rnd) {
                float best = -INFINITY; int bi = -1;
#pragma unroll
                for (int j = 0; j < 7; ++j) { const bool c = (j < own) && !((sel >> j) & 1u) && (g[j] > best); best = c ? g[j] : best; bi = c ? j : bi; }
                if (bi >= 0) sel |= 1u << bi;
            }
        }
    }
    float negm;
    {
        float qss = 0.f;
#pragma unroll
        for (int s = 0; s < NS; ++s)
#pragma unroll
            for (int e = 0; e < 8; ++e) { const float f = bf2f((unsigned short)qf[s][e]); qss += f * f; }
        qss += __shfl_xor(qss, 32);
        float gmx = fmaxf(fabsf(A.gk_n[lane]), fabsf(A.gk_n[lane + 64]));
        float grx = (DQK == 192) ? fabsf(A.gk_r[lane]) : 0.f;
        float bmx = (MOBA && lane < 32) ? fabsf(A.relb[lane * 8 + h]) * 1.4426950408889634f : 0.f;
#pragma unroll
        for (int o_ = 1; o_ < 64; o_ <<= 1) { gmx = fmaxf(gmx, __shfl_xor(gmx, o_)); grx = fmaxf(grx, __shfl_xor(grx, o_)); bmx = fmaxf(bmx, __shfl_xor(bmx, o_)); }
        negm = -(sqrtf(qss * (128.0f * gmx * gmx + 64.0f * grx * grx)) * 1.01f + bmx + 0.01f);
    }
    const int NT = 4 * (own + 1);
    u32x4 kr0, kr1, kr2, vr0, vr1; int pkr = 0;
    kr2 = (u32x4){0u, 0u, 0u, 0u};
#define ATT_KEY0(t) ((((t) < 4) ? own * 4 + (t) : (t) - 4) * 64)
#define ATT_LOAD(t) do { const int key0_ = ATT_KEY0(t); \
        const bf16* kp_ = A.K1 + (size_t)(tb + key0_) * A.k1_pitch + h * 128; \
        kr0 = *(const u32x4*)(kp_ + (size_t)(tid >> 4) * A.k1_pitch + (tid & 15) * 8); \
        kr1 = *(const u32x4*)(kp_ + (size_t)((tid >> 4) + 32) * A.k1_pitch + (tid & 15) * 8); \
        if (DQK == 192) kr2 = *(const u32x4*)(A.K2 + (size_t)(tb + key0_ + (tid >> 3)) * 64 + (tid & 7) * 8); \
        const bf16* vp_ = A.V + (size_t)(tb + key0_) * A.v_pitch + h * 128; \
        vr0 = *(const u32x4*)(vp_ + (size_t)(tid >> 4) * A.v_pitch + (tid & 15) * 8); \
        vr1 = *(const u32x4*)(vp_ + (size_t)((tid >> 4) + 32) * A.v_pitch + (tid & 15) * 8); \
        if (MOBA && tid < 64) pkr = A.pos[tb + key0_ + tid]; } while (0)
#define ATT_WRITE(buf) do { lptr kb_ = lds + L::OFF_K + (buf) * L::KBUF; lptr vb_ = lds + L::OFF_V + (buf) * L::VBUF; \
        *(LAS u32x4*)(kb_ + (tid >> 4) * L::KROW + (tid & 15) * 16) = kr0; \
        *(LAS u32x4*)(kb_ + ((tid >> 4) + 32) * L::KROW + (tid & 15) * 16) = kr1; \
        if (DQK == 192) *(LAS u32x4*)(kb_ + (tid >> 3) * L::KROW + 256 + (tid & 7) * 16) = kr2; \
        *(LAS u32x4*)(vb_ + (tid >> 4) * VROW + (tid & 15) * 16) = vr0; \
        *(LAS u32x4*)(vb_ + ((tid >> 4) + 32) * VROW + (tid & 15) * 16) = vr1; \
        if (MOBA && tid < 64) ((LAS int*)(lds + L::OFF_POS + (buf) * 256))[tid] = pkr; } while (0)

    f32x16 o[4];
#pragma unroll
    for (int d = 0; d < 4; ++d)
#pragma unroll
        for (int r = 0; r < 16; ++r) o[d][r] = 0.f;
    float lrow = 0.f;

    ATT_LOAD(0); ATT_WRITE(0);
    if (NT > 1) ATT_LOAD(1);
    __syncthreads();
    for (int t = 0; t < NT; ++t) {
        const int buf = t & 1;
        if (t + 1 < NT) { ATT_WRITE(buf ^ 1); if (t + 2 < NT) ATT_LOAD(t + 2); }
        const int tt = t & 3; const bool diag = t < 4; const int blk = diag ? own : ((t - 4) >> 2);
        const bool lsel = diag || ((sel >> blk) & 1u);
        bool act;
        if (diag) act = (64 * tt < 32 * (wid + 1));
        else act = MOBA ? (__ballot(lsel) != 0ull) : true;
        if (act) {
            lptr kb = lds + L::OFF_K + buf * L::KBUF + r32 * L::KROW + 16 * hi;
            f32x16 s0, s1;
#pragma unroll
            for (int r = 0; r < 16; ++r) { s0[r] = negm; s1[r] = negm; }
            {
                bf16x8 ka[2][2], kc[2][2];
#pragma unroll
                for (int i = 0; i < 2; ++i) { ka[0][i] = *(const LAS bf16x8*)(kb + 32 * i); kc[0][i] = *(const LAS bf16x8*)(kb + 32 * L::KROW + 32 * i); }
                __builtin_amdgcn_sched_barrier(0);
#pragma unroll
                for (int sb = 0; sb < NS; sb += 2) {
                    const int cur = (sb >> 1) & 1, nxt = cur ^ 1;
                    if (sb + 2 < NS) {
#pragma unroll
                        for (int i = 0; i < 2; ++i) { ka[nxt][i] = *(const LAS bf16x8*)(kb + 32 * (sb + 2 + i)); kc[nxt][i] = *(const LAS bf16x8*)(kb + 32 * L::KROW + 32 * (sb + 2 + i)); }
                    }
                    __builtin_amdgcn_sched_barrier(0);
#pragma unroll
                    for (int i = 0; i < 2; ++i) { s0 = MFMA32(ka[cur][i], qf[sb + i], s0); s1 = MFMA32(kc[cur][i], qf[sb + i], s1); }
                    __builtin_amdgcn_sched_barrier(0);
                }
            }
            if (MOBA) {
                const LAS int* pp = (const LAS int*)(lds + L::OFF_POS + buf * 256);
#pragma unroll
                for (int a = 0; a < 4; ++a) {
                    const i32x4 p0 = *(const LAS i32x4*)(pp + 8 * a + 4 * hi), p1 = *(const LAS i32x4*)(pp + 32 + 8 * a + 4 * hi);
                    const int pa[4] = {p0.x, p0.y, p0.z, p0.w}, pb[4] = {p1.x, p1.y, p1.z, p1.w};
#pragma unroll
                    for (int e = 0; e < 4; ++e) {
                        int d0 = pq - pa[e]; d0 = d0 < 0 ? 0 : (d0 > 1023 ? 1023 : d0);
                        int d1 = pq - pb[e]; d1 = d1 < 0 ? 0 : (d1 > 1023 ? 1023 : d1);
                        s0[4 * a + e] += lut[d0]; s1[4 * a + e] += lut[d1];
                    }
                }
                if (!lsel) {
#pragma unroll
                    for (int r = 0; r < 16; ++r) { s0[r] = NEG; s1[r] = NEG; }
                }
            }
            if (diag) {
#pragma unroll
                for (int r = 0; r < 16; ++r) {
                    const int kl = 64 * tt + (r & 3) + 8 * (r >> 2) + 4 * hi;
                    if (kl > qrel) s0[r] = NEG;
                    if (kl + 32 > qrel) s1[r] = NEG;
                }
            }
            float ls = 0.f;
#pragma unroll
            for (int r = 0; r < 16; ++r) { s0[r] = __builtin_amdgcn_exp2f(s0[r]); s1[r] = __builtin_amdgcn_exp2f(s1[r]); ls += s0[r] + s1[r]; }
            lrow += ls;
            bf16x8 pb[4];
#pragma unroll
            for (int g = 0; g < 2; ++g) {
                u32x4 w0, w1;
                w0.x = cvt_pk_bf16(s0[8 * g + 0], s0[8 * g + 1]); w0.y = cvt_pk_bf16(s0[8 * g + 2], s0[8 * g + 3]); w0.z = cvt_pk_bf16(s0[8 * g + 4], s0[8 * g + 5]); w0.w = cvt_pk_bf16(s0[8 * g + 6], s0[8 * g + 7]);
                w1.x = cvt_pk_bf16(s1[8 * g + 0], s1[8 * g + 1]); w1.y = cvt_pk_bf16(s1[8 * g + 2], s1[8 * g + 3]); w1.z = cvt_pk_bf16(s1[8 * g + 4], s1[8 * g + 5]); w1.w = cvt_pk_bf16(s1[8 * g + 6], s1[8 * g + 7]);
                pb[g] = __builtin_bit_cast(bf16x8, w0); pb[2 + g] = __builtin_bit_cast(bf16x8, w1);
            }
            lptr vb = lds + L::OFF_V + buf * L::VBUF + (4 * hi + ((lane & 15) >> 2)) * VROW + ((lane >> 4) & 1) * 32 + (lane & 3) * 8;
#pragma unroll
            for (int d = 0; d < 4; ++d) {
                s16x4 lo[4], hi4[4];
#pragma unroll
                for (int g = 0; g < 4; ++g) {
                    lo[g] = __builtin_bit_cast(s16x4, __builtin_amdgcn_ds_read_tr16_b64_v4i16((LAS s16x4*)(vb + (16 * g) * VROW + d * 64)));
                    hi4[g] = __builtin_bit_cast(s16x4, __builtin_amdgcn_ds_read_tr16_b64_v4i16((LAS s16x4*)(vb + (16 * g + 8) * VROW + d * 64)));
                }
                __builtin_amdgcn_sched_barrier(0);
#pragma unroll
                for (int g = 0; g < 4; ++g) {
                    const bf16x8 av = __builtin_shufflevector(lo[g], hi4[g], 0, 1, 2, 3, 4, 5, 6, 7);
                    o[d] = MFMA32(av, pb[g], o[d]);
                }
            }
        }
        __syncthreads();
    }
    lrow += __shfl_xor(lrow, 32);
    const float inv = 1.0f / lrow;
    bf16* op = A.O + (size_t)qrow * 1024 + h * 128 + 4 * hi;
#pragma unroll
    for (int d = 0; d < 4; ++d)
#pragma unroll
        for (int a = 0; a < 4; ++a) {
            u32x2 w; w.x = cvt_pk_bf16(o[d][4 * a] * inv, o[d][4 * a + 1] * inv); w.y = cvt_pk_bf16(o[d][4 * a + 2] * inv, o[d][4 * a + 3] * inv);
            *(u32x2*)(op + 32 * d + 8 * a) = w;
        }
#undef ATT_KEY0
#undef ATT_LOAD
#undef ATT_WRITE
}

template <int DQK, bool MOBA>
__device__ __forceinline__ void attn_phase(const Args& A, lptr lds, int vcu, int G) {
    for (int v = vcu; v < 256; v += G) {
        const int x = v >> 5, c = v & 31, gq = c >> 3, k = c & 7;
#pragma unroll 1
        for (int r = 0; r < 4; ++r) {
            const int bh = x * 16 + r * 4 + gq;
            const int k2 = (k + 4) & 7;
            const int qb = (r == 0) ? k : (r == 1) ? 7 - k : (r == 2) ? k2 : 7 - k2;
            attn_unit<DQK, MOBA>(A, bh / NH, bh % NH, qb, lds);
        }
    }
}
}

constexpr size_t MiB = 1u << 20;
constexpr size_t WS_SSQ = 500 * MiB;
constexpr int SSQ_ATTN = 0, SSQ_MLP = 1, SSQ_CQ = 2, SSQ_CKV = 3, SSQ_N = 4;
constexpr size_t WS_COS = 2 * MiB, WS_SIN = 6 * MiB, WS_LUT = 10 * MiB, WS_KMEAN = 10 * MiB + 512 * 1024;
constexpr size_t WS_CTL = 11 * MiB, CTL_BYTES = 65536;
constexpr size_t WS_W = 12 * MiB;
constexpr size_t W_MLA_IN = 0, W_MLA_UQ = W_MLA_IN + (size_t)768 * 1024 * 2, W_MLA_UKV = W_MLA_UQ + (size_t)1536 * 384 * 2, W_MLA_O = W_MLA_UKV + (size_t)2048 * 256 * 2, W_MLA_SZ = W_MLA_O + (size_t)1024 * 1024 * 2;
constexpr size_t W_MOBA_QKV = 0, W_MOBA_O = (size_t)3072 * 1024 * 2, W_MOBA_SZ = W_MOBA_O + (size_t)1024 * 1024 * 2;
constexpr size_t W_MLP_IN = 0, W_MLP_OUT = (size_t)4096 * 1024 * 2, W_MLP_SZ = 2 * W_MLP_OUT;
constexpr size_t WS_WMLA = WS_W, WS_WMOBA = WS_WMLA + 2 * W_MLA_SZ, WS_WMLP = WS_WMOBA + 2 * W_MOBA_SZ, WS_WEND = WS_WMLP + 4 * W_MLP_SZ;
constexpr size_t WS_XB = 104 * MiB;
constexpr size_t WS_BIG = 168 * MiB;
constexpr size_t WS_H = WS_BIG;
constexpr size_t WS_Q = WS_BIG, WS_KN = WS_BIG + 96 * MiB, WS_VRAW = WS_BIG + 160 * MiB, WS_VT = WS_BIG + 224 * MiB, WS_O_MLA = WS_VT, WS_KPE = WS_BIG + 288 * MiB, WS_CQ = WS_BIG + 292 * MiB, WS_CKV = WS_BIG + 316 * MiB;
constexpr size_t WS_QKV = WS_BIG, WS_VT2 = WS_BIG + 192 * MiB, WS_O_MOBA = WS_BIG + 256 * MiB;
constexpr size_t WS_END = 512 * MiB;
static_assert(WS_WEND <= WS_XB && WS_CKV + 16 * MiB <= WS_SSQ && WS_O_MOBA + 64 * MiB <= WS_SSQ && WS_SSQ + 8 * MiB <= WS_END && WS_CKV + 16 * MiB <= WS_END && WS_O_MOBA + 64 * MiB <= WS_END && WS_H + 256 * MiB <= WS_END, "ws map");

constexpr int LDS_BYTES = 147456;
constexpr int NWAVES = 8;

struct KArgs {
    const float* x; const int* pos; const float* relb; const float* attn_norm; const float* mlp_norm;
    const float* mla_w_in; const float* mla_qa; const float* mla_kva; const float* mla_w_uq; const float* mla_w_ukv;
    const float* mla_qn; const float* mla_qr; const float* mla_kn; const float* mla_kr; const float* mla_w_o;
    const float* moba_w_qkv; const float* moba_qn; const float* moba_kn; const float* moba_w_o;
    const float* mlp_w_in; const float* mlp_w_out;
    float* out; unsigned char* ws;
    int use_cg_sync; int pad;
};

__device__ __forceinline__ float wave_sum(float v) {
#pragma unroll
    for (int o = 1; o < 64; o <<= 1) v += __shfl_xor(v, o);
    return v;
}

__device__ __forceinline__ void transpose_item(const float* W, const float* gain, int K, int N, bf16* WT, LAS float* scr, int item, int lane) {
    const int nblk = N / 32, kb = item / nblk, nb = item % nblk, k0 = 64 * kb, n0 = 32 * nb;
    float wv[32];
#pragma unroll
    for (int i = 0; i < 32; ++i) { const int kk = 2 * i + (lane >> 5); wv[i] = __builtin_nontemporal_load(W + (size_t)(k0 + kk) * N + n0 + (lane & 31)); }
#pragma unroll
    for (int i = 0; i < 32; ++i) { const int kk = 2 * i + (lane >> 5); const float g = gain ? gain[k0 + kk] : 1.f; scr[kk * 33 + (lane & 31)] = g * wv[i]; }
    asm volatile("s_waitcnt lgkmcnt(0)" ::: "memory");
    const int c = lane & 7;
#pragma unroll
    for (int j = 0; j < 4; ++j) { const int n = (lane >> 3) + 8 * j; const LAS float* s = scr + (8 * c) * 33 + n;
        u32x4 o; o.x = cvt_pk_bf16(s[0 * 33], s[1 * 33]); o.y = cvt_pk_bf16(s[2 * 33], s[3 * 33]); o.z = cvt_pk_bf16(s[4 * 33], s[5 * 33]); o.w = cvt_pk_bf16(s[6 * 33], s[7 * 33]);
        asm volatile("global_store_dwordx4 %0, %1, off sc1\n\ts_nop 1" :: "v"(WT + (size_t)(n0 + n) * K + k0 + 8 * c), "v"(o) : "memory"); }
    asm volatile("s_waitcnt lgkmcnt(0)" ::: "memory");
}

__device__ __forceinline__ void unpack8(const u32x4 v, float (&f)[8]) {
    f[0] = bflo(v.x); f[1] = bfhi(v.x); f[2] = bflo(v.y); f[3] = bfhi(v.y); f[4] = bflo(v.z); f[5] = bfhi(v.z); f[6] = bflo(v.w); f[7] = bfhi(v.w);
}
__device__ __forceinline__ u32x4 pack8(const float (&f)[8]) {
    u32x4 w; w.x = cvt_pk_bf16(f[0], f[1]); w.y = cvt_pk_bf16(f[2], f[3]); w.z = cvt_pk_bf16(f[4], f[5]); w.w = cvt_pk_bf16(f[6], f[7]); return w;
}

#define XB_TMO      128
#define XB_XCNT(j)  (256  + 64 * (j))
#define XB_XSUB(j)  (1280 + 64 * (j))
#define XB_XGEN(j)  (2304 + 64 * (j))
#define XB_TOP      3328
#define XB_TOPGEN   3392
#define XCD_BAR_WORDS 3456
#define XB_SPIN_CAP (1u << 18)

__device__ __forceinline__ unsigned xb_ld(unsigned* p)              { return __hip_atomic_load(p, __ATOMIC_RELAXED, __HIP_MEMORY_SCOPE_AGENT); }
__device__ __forceinline__ unsigned xb_add(unsigned* p, unsigned v) { return __hip_atomic_fetch_add(p, v, __ATOMIC_RELAXED, __HIP_MEMORY_SCOPE_AGENT); }
__device__ __forceinline__ unsigned xb_xcc_id() { return (unsigned)__builtin_amdgcn_s_getreg((3 << 11) | 20) & 0xFu; }
#define XB_SPIN(cond, bar) do { unsigned _sp = 0; while (cond) { __builtin_amdgcn_s_sleep(1); \
    if ((++_sp & 255u) == 0u) { if (xb_ld(&(bar)[XB_TMO])) break; if (_sp > XB_SPIN_CAP) { atomicAdd(&(bar)[XB_TMO], 1u); break; } } } } while (0)

struct XcdBarrier {
    unsigned* bar; unsigned x;
    volatile LAS unsigned* st;
};

__device__ __forceinline__ XcdBarrier xcd_barrier_post(unsigned* bar, volatile LAS unsigned* st) {
    XcdBarrier b; b.bar = bar; b.x = xb_xcc_id(); b.st = st;
    if (threadIdx.x == 0) (void)xb_add(&bar[XB_XCNT(b.x)], 1u);
    return b;
}
__device__ __forceinline__ void xcd_barrier_complete(unsigned* bar, unsigned x, unsigned& nloc, unsigned& nx) {
    const unsigned G = gridDim.x * gridDim.y * gridDim.z;
    unsigned sum, cnt, mine, sp = 0u;
    for (;;) {
        sum = 0u; cnt = 0u; mine = 0u;
#pragma unroll
        for (unsigned j = 0; j < 16; ++j) { const unsigned c = xb_ld(&bar[XB_XCNT(j)]); sum += c; cnt += (c > 0u) ? 1u : 0u; mine = (j == x) ? c : mine; }
        if (sum == G) break;
        __builtin_amdgcn_s_sleep(1);
        if ((++sp & 255u) == 0u) { if (xb_ld(&bar[XB_TMO])) break; if (sp > XB_SPIN_CAP) { atomicAdd(&bar[XB_TMO], 1u); break; } }
    }
    nloc = mine > 0u ? mine : 1u; nx = cnt > 0u ? cnt : 1u;
}

__device__ __forceinline__ void xcd_barrier(const XcdBarrier& b) {
    asm volatile("s_waitcnt vmcnt(0)" ::: "memory");
    __syncthreads();
    if (threadIdx.x == 0) {
        unsigned* bar = b.bar;
        __builtin_amdgcn_s_waitcnt(0);
        unsigned nloc = b.st[0], nx = b.st[1];
        if (nloc == 0u) { xcd_barrier_complete(bar, b.x, nloc, nx); b.st[0] = nloc; b.st[1] = nx; }
        const unsigned old = xb_add(&bar[XB_XSUB(b.x)], 1u);
        const unsigned gen = old / nloc;
        if (old + 1u == (gen + 1u) * nloc) {
            __builtin_amdgcn_fence(__ATOMIC_RELEASE, "agent");
            asm volatile("s_waitcnt vmcnt(0)" ::: "memory");
            const unsigned og = xb_add(&bar[XB_TOP], 1u);
            const unsigned tg = og / nx;
            if (og + 1u == (tg + 1u) * nx) xb_add(&bar[XB_TOPGEN], 1u);
            else XB_SPIN(xb_ld(&bar[XB_TOPGEN]) == tg, bar);
            __builtin_amdgcn_fence(__ATOMIC_ACQUIRE, "agent");
            xb_add(&bar[XB_XGEN(b.x)], 1u);
            asm volatile("s_waitcnt vmcnt(0)" ::: "memory");
        } else {
            XB_SPIN(xb_ld(&bar[XB_XGEN(b.x)]) == gen, bar);
            __builtin_amdgcn_fence(__ATOMIC_ACQUIRE, "agent");
            asm volatile("s_waitcnt vmcnt(0)" ::: "memory");
        }
    }
    __syncthreads();
}

__global__ void __launch_bounds__(512) fwd_megakernel(KArgs a) {
    extern __shared__ __attribute__((aligned(16))) unsigned char lds_raw[];
    cg::grid_group grid = cg::this_grid();
    lptr lds = (lptr)lds_raw;
    const int wave = __builtin_amdgcn_readfirstlane(threadIdx.x >> 6);
    const int G = gridDim.x, bx = blockIdx.x;
    volatile LAS unsigned* MISC = (volatile LAS unsigned*)(lds + 131072);
    if (threadIdx.x < 16) MISC[threadIdx.x] = 0u;
    __syncthreads();
    XcdBarrier xbar = xcd_barrier_post((unsigned*)(a.ws + WS_CTL), MISC + 8);
#define GRID_SYNC() do { xcd_barrier(xbar); } while (0)
#define OPAQUE_TID() int tid = threadIdx.x; asm volatile("" : "+v"(tid)); const int lane = tid & 63
    const int vcu = (G % 8 == 0) ? (bx % 8) * (G / 8) + bx / 8 : bx;
    const int gw = vcu * NWAVES + wave, NGW = G * NWAVES;
    unsigned char* ws = a.ws;
    float* ssq = (float*)(ws + WS_SSQ);
    float* cosT = (float*)(ws + WS_COS); float* sinT = (float*)(ws + WS_SIN);
    float* lutG = (float*)(ws + WS_LUT); float* kmeanG = (float*)(ws + WS_KMEAN);
    bf16* XB = (bf16*)(ws + WS_XB);
    constexpr float LOG2E = 1.4426950408889634f;

    {
        OPAQUE_TID();
        LAS float* scr = (LAS float*)(lds + wave * 16384);
        int item_base = 0;
        for (int mi = 0; mi < 20; ++mi) {
            const float* W; const float* gain; bf16* WT; int K, N;
            if (mi < 8) { const int j = mi >> 2, kind = mi & 3; unsigned char* wb = ws + WS_WMLA + j * W_MLA_SZ;
                if (kind == 0) { W = a.mla_w_in + (size_t)j * 1024 * 704; gain = a.attn_norm + (2 * j) * 1024; K = 1024; N = 704; WT = (bf16*)(wb + W_MLA_IN); }
                else if (kind == 1) { W = a.mla_w_uq + (size_t)j * 384 * 1536; gain = a.mla_qa + j * 384; K = 384; N = 1536; WT = (bf16*)(wb + W_MLA_UQ); }
                else if (kind == 2) { W = a.mla_w_ukv + (size_t)j * 256 * 2048; gain = a.mla_kva + j * 256; K = 256; N = 2048; WT = (bf16*)(wb + W_MLA_UKV); }
                else { W = a.mla_w_o + (size_t)j * 1024 * 1024; gain = nullptr; K = 1024; N = 1024; WT = (bf16*)(wb + W_MLA_O); } }
            else if (mi < 12) { const int j = (mi - 8) >> 1, kind = (mi - 8) & 1; unsigned char* wb = ws + WS_WMOBA + j * W_MOBA_SZ;
                if (kind == 0) { W = a.moba_w_qkv + (size_t)j * 1024 * 3072; gain = a.attn_norm + (2 * j + 1) * 1024; K = 1024; N = 3072; WT = (bf16*)(wb + W_MOBA_QKV); }
                else { W = a.moba_w_o + (size_t)j * 1024 * 1024; gain = nullptr; K = 1024; N = 1024; WT = (bf16*)(wb + W_MOBA_O); } }
            else { const int i = (mi - 12) >> 1, kind = (mi - 12) & 1; unsigned char* wb = ws + WS_WMLP + i * W_MLP_SZ;
                if (kind == 0) { W = a.mlp_w_in + (size_t)i * 1024 * 4096; gain = a.mlp_norm + i * 1024; K = 1024; N = 4096; WT = (bf16*)(wb + W_MLP_IN); }
                else { W = a.mlp_w_out + (size_t)i * 4096 * 1024; gain = nullptr; K = 4096; N = 1024; WT = (bf16*)(wb + W_MLP_OUT); } }
            const int nitems = (K / 64) * (N / 32);
            int it0 = gw - item_base % NGW; if (it0 < 0) it0 += NGW;
            for (int it = it0; it < nitems; it += NGW) transpose_item(W, gain, K, N, WT, scr, it, lane);
            item_base += nitems;
        }
        for (int i = gw * 64 + lane; i < 2 * 64 * 1024 / 8; i += NGW * 64) { const int j = i / (64 * 1024 / 8), r = i % (64 * 1024 / 8);
            *(u32x4*)(ws + WS_WMLA + j * W_MLA_SZ + W_MLA_IN + (size_t)704 * 1024 * 2 + (size_t)r * 16) = (u32x4){0u, 0u, 0u, 0u}; }
        for (int m0 = gw * 4; m0 < TOK; m0 += NGW * 4) {
            f32x4 v[4][4];
#pragma unroll
            for (int r = 0; r < 4; ++r) { const f32x4* xr = (const f32x4*)(a.x + (size_t)(m0 + r) * DM) + lane;
#pragma unroll
                for (int j = 0; j < 4; ++j) v[r][j] = __builtin_nontemporal_load(xr + 64 * j); }
#pragma unroll
            for (int r = 0; r < 4; ++r) { const int m = m0 + r; float s = 0.f;
#pragma unroll
                for (int j = 0; j < 4; ++j) s += (v[r][j].x * v[r][j].x + v[r][j].y * v[r][j].y) + (v[r][j].z * v[r][j].z + v[r][j].w * v[r][j].w);
                s = wave_sum(s); if (lane < 16) ssq[(size_t)m * 16 + lane] = (lane == 0) ? s : 0.f;
                u32x2* o8 = (u32x2*)(XB + (size_t)m * DM) + lane;
#pragma unroll
                for (int j = 0; j < 4; ++j) { u32x2 w; w.x = cvt_pk_bf16(v[r][j].x, v[r][j].y); w.y = cvt_pk_bf16(v[r][j].z, v[r][j].w); o8[64 * j] = w; } }
        }
        for (int i = bx * 512 + tid; i < TOK * 32; i += G * 512) { const int tok = i >> 5, f = i & 31;
            const float inv_freq = powf(10000.0f, -(float)(2 * f) / 64.0f);
            const float ang = (float)a.pos[tok] * inv_freq; float sv, cv; sincosf(ang, &sv, &cv); cosT[i] = cv; sinT[i] = sv; }
        for (int i = bx * 512 + tid; i < 8 * 1024; i += G * 512) { const int hh = i >> 10, n = i & 1023; int bk;
            if (n < 16) bk = n; else { const float nf = (float)n; bk = 16 + (int)(logf(nf / 16.0f) / 4.1588830833596715f * 16.0f); bk = bk > 31 ? 31 : bk; }
            lutG[i] = a.relb[bk * 8 + hh] * LOG2E; }
    }
    if (a.use_cg_sync) { grid.sync(); __builtin_amdgcn_fence(__ATOMIC_ACQUIRE, "agent"); } else GRID_SYNC();

#pragma unroll 1
    for (int layer = 0; layer < 4; ++layer) {
        const int j = layer >> 1; const bool is_mla = (layer & 1) == 0;
        float* ssq_attn = ssq + (size_t)SSQ_ATTN * TOK * 16; float* ssq_attn_next = ssq_attn; float* ssq_mlp = ssq + (size_t)SSQ_MLP * TOK * 16;
        const bf16* Oattn; const bf16* Wo_t;
        unsigned char* wbl = is_mla ? (ws + WS_WMLA + j * W_MLA_SZ) : (ws + WS_WMOBA + j * W_MOBA_SZ);
        bf16* CQ = (bf16*)(ws + WS_CQ); bf16* CKV = (bf16*)(ws + WS_CKV); bf16* KPE = (bf16*)(ws + WS_KPE);
        bf16* Q = (bf16*)(ws + WS_Q); bf16* KN = (bf16*)(ws + WS_KN); bf16* VRAW = (bf16*)(ws + WS_VRAW);
        bf16* QKV = (bf16*)(ws + WS_QKV);
        float* ssq_cq = ssq + (size_t)SSQ_CQ * TOK * 16; float* ssq_ckv = ssq + (size_t)SSQ_CKV * TOK * 16;
        if (is_mla) {
            {
                pg8::Gemm g{XB, (const bf16*)(wbl + W_MLA_IN), TOK, 768, 1024}; pg8::StaticOrder S; S.init(TOK, 768, G, bx);
                pg8::EpiGen<2> E{nullptr, 0, 0.f, CQ, 0, CKV, KPE, 0, ssq_cq, ssq_ckv, nullptr, nullptr, nullptr, nullptr, 0, (pg8::PG8_LAS_F)(lds + 131072 + 256)};
                pg8::gemm_phase<pg8::EpiGen<2>, pg8::StaticOrder, true, true>(lds, g, S, E);
            }
            GRID_SYNC();
            {
                OPAQUE_TID();
                const float* g_kr = a.mla_kr + j * 64;
                float gr[8];
#pragma unroll
                for (int e = 0; e < 8; ++e) gr[e] = g_kr[8 * (lane & 7) + e];
                for (int t0 = gw * 8; t0 < TOK; t0 += NGW * 8) {
                    const int tok = t0 + (lane >> 3), c = lane & 7;
                    bf16* ptr = KPE + (size_t)tok * 64 + c * 8;
                    const u32x4 v = *(const u32x4*)ptr;
                    const f32x4 c0 = *(const f32x4*)(cosT + tok * 32 + 8 * (c & 3)), c1 = *(const f32x4*)(cosT + tok * 32 + 8 * (c & 3) + 4);
                    const f32x4 s0 = *(const f32x4*)(sinT + tok * 32 + 8 * (c & 3)), s1 = *(const f32x4*)(sinT + tok * 32 + 8 * (c & 3) + 4);
                    float f[8]; unpack8(v, f);
                    float ss = 0.f;
#pragma unroll
                    for (int e = 0; e < 8; ++e) ss += f[e] * f[e];
                    ss += __shfl_xor(ss, 1); ss += __shfl_xor(ss, 2); ss += __shfl_xor(ss, 4);
                    const float sc = __builtin_amdgcn_rsqf(ss * (1.0f / 64.0f) + pg8::RMS_EPS_F);
                    float y[8];
#pragma unroll
                    for (int e = 0; e < 8; ++e) y[e] = f[e] * sc * gr[e];
#pragma unroll
                    for (int e = 0; e < 8; ++e) { const float pe = __shfl_xor(y[e], 4); const float cc = e < 4 ? c0[e & 3] : c1[e & 3], sn = e < 4 ? s0[e & 3] : s1[e & 3];
                        y[e] = (c & 4) ? (y[e] * cc + pe * sn) : (y[e] * cc - pe * sn); }
                    *(u32x4*)ptr = pack8(y);
                }
            }
            {
                int kq = 384; asm volatile("" : "+s"(kq));
                pg8::Gemm g{CQ, (const bf16*)(wbl + W_MLA_UQ), TOK, 1536, kq}; pg8::StaticOrder S; S.init(TOK, 1536, G, bx);
                pg8::EpiGen<0> E{nullptr, 0, 0.f, Q, 1536, nullptr, nullptr, 0, nullptr, nullptr, nullptr, nullptr, nullptr, nullptr, 0, (pg8::PG8_LAS_F)(lds + 131072 + 256)};
                pg8::gemm_phase<pg8::EpiGen<0>, pg8::StaticOrder, true, true>(lds, g, S, E);
            }
        }
        {
            pg8::Gemm g; pg8::EpiGen<4> E;
            pg8::PG8_LAS_F xl = (pg8::PG8_LAS_F)(lds + 131072 + 256);
            if (is_mla) { g = pg8::Gemm{CKV, (const bf16*)(wbl + W_MLA_UKV), TOK, 2048, 256};
                E = pg8::EpiGen<4>{ssq_ckv, 8, 1.0f / 256.0f, KN, 1024, VRAW, nullptr, 1, nullptr, nullptr, nullptr, nullptr, a.mla_kn + j * 128, nullptr, 1, xl}; }
            else { g = pg8::Gemm{XB, (const bf16*)(wbl + W_MOBA_QKV), TOK, 3072, 1024};
                E = pg8::EpiGen<4>{ssq_attn, 16, 1.0f / 1024.0f, QKV, 3072, nullptr, nullptr, 0, nullptr, nullptr, nullptr, nullptr, a.moba_kn + j * 128, kmeanG, 2, xl}; }
            pg8::StaticOrder S; S.init(g.M, g.N, G, bx);
            pg8::gemm_phase<pg8::EpiGen<4>, pg8::StaticOrder, true, true>(lds, g, S, E);
        }
        GRID_SYNC();
        if (is_mla) {
            att::Args AA{Q, 1536, KN, 1024, KPE, VRAW, 1024, (bf16*)(ws + WS_O_MLA), nullptr, nullptr, nullptr, a.mla_qn + j * 128, a.mla_qr + j * 64, cosT, sinT, 0.07216878364870322f * LOG2E, a.mla_kn + j * 128, a.mla_kr + j * 64, nullptr};
            att::attn_phase<192, false>(AA, lds, vcu, G);
            Oattn = (const bf16*)(ws + WS_O_MLA); Wo_t = (const bf16*)(wbl + W_MLA_O);
        } else {
            att::Args AA{QKV, 3072, QKV + 1024, 3072, nullptr, QKV + 2048, 3072, (bf16*)(ws + WS_O_MOBA), a.pos, lutG, kmeanG, a.moba_qn + j * 128, nullptr, nullptr, nullptr, 0.08838834764831845f * LOG2E, a.moba_kn + j * 128, nullptr, a.relb};
            att::attn_phase<128, true>(AA, lds, vcu, G);
            Oattn = (const bf16*)(ws + WS_O_MOBA); Wo_t = (const bf16*)(wbl + W_MOBA_O);
        }
        GRID_SYNC();
        unsigned char* wm = ws + WS_WMLP + layer * W_MLP_SZ;
#pragma unroll 1
        for (int rep = 0; rep < 2; ++rep) {
            {
                pg8::Gemm g; pg8::EpiGen<3> E;
                if (rep == 0) { g = pg8::Gemm{Oattn, Wo_t, TOK, 1024, 1024}; E = pg8::EpiGen<3>{nullptr, 0, 0.f, XB, 1024, nullptr, nullptr, 0, ssq_mlp, nullptr, nullptr, nullptr}; }
                else { g = pg8::Gemm{(const bf16*)(ws + WS_H), (const bf16*)(wm + W_MLP_OUT), TOK, 1024, 4096}; E = pg8::EpiGen<3>{ssq_mlp, 16, 1.0f / 1024.0f, XB, 1024, nullptr, nullptr, 0, (layer == 3) ? nullptr : ssq_attn_next, nullptr, nullptr, (layer == 3) ? a.out : nullptr, nullptr, nullptr, 0, (pg8::PG8_LAS_F)(lds + 131072 + 256)}; }
                pg8::StaticOrder S; S.init(g.M, g.N, G, bx);
                pg8::gemm_phase<pg8::EpiGen<3>, pg8::StaticOrder, true, true>(lds, g, S, E);
            }
            if (rep == 0) {
                GRID_SYNC();
                pg8::Gemm g{XB, (const bf16*)(wm + W_MLP_IN), TOK, 4096, 1024}; pg8::StaticOrder S; S.init(TOK, 4096, G, bx);
                pg8::EpiGen<1> E{nullptr, 0, 0.f, (bf16*)(ws + WS_H), 4096, nullptr, nullptr, 0, nullptr, nullptr, nullptr, nullptr, nullptr, nullptr, 0, (pg8::PG8_LAS_F)(lds + 131072 + 256)};
                pg8::gemm_phase<pg8::EpiGen<1>, pg8::StaticOrder, true, true>(lds, g, S, E);
                GRID_SYNC();
            }
        }
        if (layer < 3) GRID_SYNC();
    }
}

extern "C" void kernel_launch(void* const* d_in, const int* in_sizes, int n_in, void* d_out, int out_size, void* d_ws, size_t ws_size, hipStream_t stream) {
    static int grid = 0;
    if (grid == 0) {
        if (n_in != 21 || out_size != TOK * DM || ws_size < WS_END) { fprintf(stderr, "kernel_launch: unexpected shapes (n_in %d out %d ws %zu)\n", n_in, out_size, ws_size); grid = -1; return; }
        int dev = 0, cus = 0, per_cu = 0;
        (void)hipGetDevice(&dev);
        (void)hipDeviceGetAttribute(&cus, hipDeviceAttributeMultiprocessorCount, dev);
        (void)hipFuncSetAttribute((const void*)fwd_megakernel, hipFuncAttributeMaxDynamicSharedMemorySize, LDS_BYTES);
        (void)hipOccupancyMaxActiveBlocksPerMultiprocessor(&per_cu, (const void*)fwd_megakernel, 512, LDS_BYTES);
        if (per_cu < 1) per_cu = 1;
        grid = cus * per_cu;
        (void)hipGetLastError();
    }
    if (grid < 0) return;
    KArgs a{};
    a.x = (const float*)d_in[0]; a.pos = (const int*)d_in[1]; a.relb = (const float*)d_in[2]; a.attn_norm = (const float*)d_in[3]; a.mlp_norm = (const float*)d_in[4];
    a.mla_w_in = (const float*)d_in[5]; a.mla_qa = (const float*)d_in[6]; a.mla_kva = (const float*)d_in[7]; a.mla_w_uq = (const float*)d_in[8]; a.mla_w_ukv = (const float*)d_in[9];
    a.mla_qn = (const float*)d_in[10]; a.mla_qr = (const float*)d_in[11]; a.mla_kn = (const float*)d_in[12]; a.mla_kr = (const float*)d_in[13]; a.mla_w_o = (const float*)d_in[14];
    a.moba_w_qkv = (const float*)d_in[15]; a.moba_qn = (const float*)d_in[16]; a.moba_kn = (const float*)d_in[17]; a.moba_w_o = (const float*)d_in[18];
    a.mlp_w_in = (const float*)d_in[19]; a.mlp_w_out = (const float*)d_in[20];
    a.out = (float*)d_out; a.ws = (unsigned char*)d_ws;
    (void)hipMemsetAsync((unsigned char*)d_ws + WS_CTL, 0, CTL_BYTES, stream);
    void* args[] = {&a};
    hipError_t e = hipLaunchCooperativeKernel((const void*)fwd_megakernel, dim3(grid), dim3(512), args, LDS_BYTES, stream);
    if (e != hipSuccess) fprintf(stderr, "cooperative launch failed: %s (grid %d)\n", hipGetErrorString(e), grid);
}
```
